# Optimizing an MI355X kernel written in HIP

```python
import jax, jax.numpy as jnp
from jax import lax
import numpy as np

D_MODEL = 1024
BATCH = 8
SEQ = 4096
DEPTH = 4

GRID_W = 64
CTX_LEN = 256
D_MIX = D_MODEL
GROUP_W = D_MIX // 4
D_FF = 4 * D_MODEL
N_MOD = 6
EPS = 1e-6
ROPE_BASE = 10000.0
Q_BLOCK = 128
CONV_WIDTH = 31
MLA_HEADS = 4
MLA_NOPE = 64
MLA_ROPE = 32
MLA_V = 64
MLA_Q_RANK = 256
MLA_KV_RANK = 128
GQA_HEADS = 4
GQA_KV_HEADS = 2
GQA_HEAD_DIM = 64
RET_HEADS = 4
RET_QK = 32
RET_V = 64
RET_CHUNK = 128

IN_SIZES = (2 * GROUP_W,
            MLA_Q_RANK, MLA_KV_RANK, MLA_ROPE,
            GQA_HEADS * GQA_HEAD_DIM, GQA_KV_HEADS * GQA_HEAD_DIM, GQA_KV_HEADS * GQA_HEAD_DIM,
            RET_HEADS * RET_QK, RET_HEADS * RET_QK, RET_HEADS * RET_V,
            GROUP_W, GROUP_W)
D_IN = sum(IN_SIZES)

kernel_name = 'hybrid_parallel_groups_flow_block'


def rms_norm(x, gain=None):
    xf = x.astype(jnp.float32)
    y = xf * lax.rsqrt(jnp.mean(xf * xf, axis=-1, keepdims=True) + EPS)
    if gain is not None:
        y = y * gain.astype(jnp.float32)
    return y.astype(x.dtype)


def layer_norm(x, gain, bias):
    xf = x.astype(jnp.float32)
    mu = jnp.mean(xf, axis=-1, keepdims=True)
    var = jnp.mean(jnp.square(xf - mu), axis=-1, keepdims=True)
    y = (xf - mu) * lax.rsqrt(var + EPS) * gain.astype(jnp.float32) + bias.astype(jnp.float32)
    return y.astype(x.dtype)


def split_cols(u):
    parts, off = [], 0
    for s in IN_SIZES:
        parts.append(u[..., off:off + s])
        off += s
    return tuple(parts)


def heads(t, n, d):
    b, l, _ = t.shape
    return t.reshape(b, l, n, d).transpose(0, 2, 1, 3)


def merge_heads(o):
    b, hk, g, l, d = o.shape
    return o.reshape(b, hk * g, l, d).transpose(0, 2, 1, 3).reshape(b, l, hk * g * d)


def flip_seq(t):
    return jnp.flip(t, axis=2)


def rope_1d(x, pos):
    half = x.shape[-1] // 2
    freqs = ROPE_BASE ** (-jnp.arange(half, dtype=jnp.float32) / half)
    ang = pos.astype(jnp.float32)[:, None] * freqs[None, :]
    cos, sin = jnp.cos(ang), jnp.sin(ang)
    xf = x.astype(jnp.float32)
    x1, x2 = xf[..., :half], xf[..., half:]
    return jnp.concatenate([x1 * cos - x2 * sin, x1 * sin + x2 * cos], axis=-1).astype(x.dtype)


def rope_2d(x, row, col):
    half = x.shape[-1] // 2
    return jnp.concatenate([rope_1d(x[..., :half], row), rope_1d(x[..., half:], col)], axis=-1)


def grouped_attention(q, k, v):
    b, hk, g, lq, dq = q.shape
    nb = lq // Q_BLOCK
    scale = dq ** -0.5
    qb = jnp.moveaxis(q.reshape(b, hk, g, nb, Q_BLOCK, dq), 3, 0)

    def one_block(qblk):
        s = jnp.einsum('bkgqd,bksd->bkgqs', qblk, k, preferred_element_type=jnp.float32) * scale
        p = jax.nn.softmax(s, axis=-1)
        return jnp.einsum('bkgqs,bksd->bkgqd', p.astype(v.dtype), v)

    o = lax.map(one_block, qb)
    return jnp.moveaxis(o, 0, 3).reshape(b, hk, g, lq, v.shape[-1])


def conformer_conv(u, w_dw, b_dw, ln_g, ln_b, w_pw):
    y = u[..., :GROUP_W] * jax.nn.sigmoid(u[..., GROUP_W:])
    pad = CONV_WIDTH // 2
    y = lax.conv_general_dilated(y, w_dw[:, None, :], window_strides=(1,), padding=((pad, pad),),
                                 dimension_numbers=('NWC', 'WIO', 'NWC'),
                                 feature_group_count=GROUP_W) + b_dw
    y = jax.nn.silu(layer_norm(y, ln_g, ln_b))
    return y @ w_pw


def mla_q(u, g, w_uq, pos):
    q = heads(rms_norm(u, g) @ w_uq, MLA_HEADS, MLA_NOPE + MLA_ROPE)
    if pos is not None:
        q = jnp.concatenate([q[..., :MLA_NOPE], rope_2d(q[..., MLA_NOPE:], *pos)], axis=-1)
    return q[:, :, None]


def mla_kv(u_kv, u_kpe, g, w_ukv, pos):
    kv = heads(rms_norm(u_kv, g) @ w_ukv, MLA_HEADS, MLA_NOPE + MLA_V)
    k_pe = u_kpe
    if pos is not None:
        k_pe = rope_2d(k_pe, *pos)
    b, h, l, _ = kv.shape
    k = jnp.concatenate([kv[..., :MLA_NOPE], jnp.broadcast_to(k_pe[:, None], (b, h, l, MLA_ROPE))], axis=-1)
    return k, kv[..., MLA_NOPE:]


def gqa_q(u, g, pos):
    q = rms_norm(heads(u, GQA_HEADS, GQA_HEAD_DIM), g)
    if pos is not None:
        q = rope_2d(q, *pos)
    b, h, l, d = q.shape
    return q.reshape(b, GQA_KV_HEADS, h // GQA_KV_HEADS, l, d)


def gqa_kv(uk, uv, g, pos):
    k = rms_norm(heads(uk, GQA_KV_HEADS, GQA_HEAD_DIM), g)
    if pos is not None:
        k = rope_2d(k, *pos)
    return k, heads(uv, GQA_KV_HEADS, GQA_HEAD_DIM)


def ret_qkv(uq, uk, uv):
    return (heads(uq, RET_HEADS, RET_QK), heads(uk, RET_HEADS, RET_QK) * (RET_QK ** -0.5),
            heads(uv, RET_HEADS, RET_V))


def retention_chunked(q, k, v, log_gamma, s0, with_output):
    b, h, l, dk = q.shape
    dv = v.shape[-1]
    n = l // RET_CHUNK
    qc = q.astype(jnp.float32).reshape(b, h, n, RET_CHUNK, dk)
    kc = k.astype(jnp.float32).reshape(b, h, n, RET_CHUNK, dk)
    vc = v.astype(jnp.float32).reshape(b, h, n, RET_CHUNK, dv)
    idx = jnp.arange(RET_CHUNK, dtype=jnp.float32)
    lg = log_gamma[:, None]
    k_decay = jnp.exp(lg * (RET_CHUNK - 1.0 - idx))
    chunk_kv = jnp.einsum('bhnjd,bhnje->bhnde', kc * k_decay[:, None, :, None], vc)
    chunk_decay = jnp.exp(log_gamma * RET_CHUNK)[:, None, None]

    def step(s, kv_j):
        return s * chunk_decay + kv_j, s

    s_final, s_prev = lax.scan(step, s0, jnp.moveaxis(chunk_kv, 2, 0))
    if not with_output:
        return None, s_final
    s_prev = jnp.moveaxis(s_prev, 0, 2)
    diff = idx[:, None] - idx[None, :]
    decay = jnp.where(diff >= 0, jnp.exp(lg[:, :, None] * jnp.maximum(diff, 0.0)), 0.0)
    scores = jnp.einsum('bhnid,bhnjd->bhnij', qc, kc) * decay[:, None]
    inner = jnp.einsum('bhnij,bhnje->bhnie', scores, vc)
    q_decay = jnp.exp(lg * (idx + 1.0))
    cross = jnp.einsum('bhnid,bhnde->bhnie', qc * q_decay[:, None, :, None], s_prev)
    return (inner + cross).reshape(b, h, l, dv), s_final


def ret_readout(o, gain, gate):
    b, h, l, d = o.shape
    y = rms_norm(o, gain[:, None, :]).transpose(0, 2, 1, 3).reshape(b, l, h * d)
    return y.astype(gate.dtype) * jax.nn.silu(gate)


def adaln(cond, w, b):
    m = (jax.nn.silu(cond) @ w + b).reshape(cond.shape[0], N_MOD, D_MODEL)
    return tuple(m[:, i, None, :] for i in range(N_MOD))


def modulate(x, shift, scale):
    return rms_norm(x) * (1.0 + scale) + shift


def sq_relu_mlp(h, w1, w2):
    return jnp.square(jax.nn.relu(h @ w1)) @ w2


def mixing_sublayer(h_ctx, h_lat, pos, ctx_out, w_in, w_out, conv_dw, conv_b, conv_ln_g, conv_ln_b,
                    conv_pw, mla_q_g, mla_kv_g, mla_uq, mla_ukv, gqa_q_g, gqa_k_g, ret_decay, ret_norm_g):
    (a_c, cq_c, ckv_c, kpe_c, q_c, k_c, v_c, rq_c, rk_c, rv_c, gf_c, gb_c) = split_cols(h_ctx @ w_in)
    (a_l, cq_l, ckv_l, kpe_l, q_l, k_l, v_l, rq_l, rk_l, rv_l, gf_l, gb_l) = split_cols(h_lat @ w_in)
    conv_args = (conv_dw, conv_b, conv_ln_g, conv_ln_b, conv_pw)
    ya_l = conformer_conv(a_l, *conv_args)
    mk_c, mv_c = mla_kv(ckv_c, kpe_c, mla_kv_g, mla_ukv, None)
    mk_l, mv_l = mla_kv(ckv_l, kpe_l, mla_kv_g, mla_ukv, pos)
    yb_l = merge_heads(grouped_attention(mla_q(cq_l, mla_q_g, mla_uq, pos),
                                         jnp.concatenate([mk_c, mk_l], axis=2),
                                         jnp.concatenate([mv_c, mv_l], axis=2)))
    gk_c, gv_c = gqa_kv(k_c, v_c, gqa_k_g, None)
    gk_l, gv_l = gqa_kv(k_l, v_l, gqa_k_g, pos)
    yc_l = merge_heads(grouped_attention(gqa_q(q_l, gqa_q_g, pos),
                                         jnp.concatenate([gk_c, gk_l], axis=2),
                                         jnp.concatenate([gv_c, gv_l], axis=2)))
    log_g = jax.nn.log_sigmoid(ret_decay.astype(jnp.float32))
    tq_c, tk_c, tv_c = ret_qkv(rq_c, rk_c, rv_c)
    tq_l, tk_l, tv_l = ret_qkv(rq_l, rk_l, rv_l)
    s0 = jnp.zeros((h_ctx.shape[0], RET_HEADS, RET_QK, RET_V), jnp.float32)
    oc_f, s_f = retention_chunked(tq_c, tk_c, tv_c, log_g[0], s0, ctx_out)
    oc_b, s_b = retention_chunked(flip_seq(tq_c), flip_seq(tk_c), flip_seq(tv_c), log_g[1], s0, ctx_out)
    ol_f, _ = retention_chunked(tq_l, tk_l, tv_l, log_g[0], s_f, True)
    ol_b, _ = retention_chunked(flip_seq(tq_l), flip_seq(tk_l), flip_seq(tv_l), log_g[1], s_b, True)
    yd_l = ret_readout(ol_f, ret_norm_g[0], gf_l) + ret_readout(flip_seq(ol_b), ret_norm_g[1], gb_l)
    y_lat = jnp.concatenate([ya_l, yb_l, yc_l, yd_l], axis=-1) @ w_out
    if not ctx_out:
        return None, y_lat
    ya_c = conformer_conv(a_c, *conv_args)
    yb_c = merge_heads(grouped_attention(mla_q(cq_c, mla_q_g, mla_uq, None), mk_c, mv_c))
    yc_c = merge_heads(grouped_attention(gqa_q(q_c, gqa_q_g, None), gk_c, gv_c))
    yd_c = ret_readout(oc_f, ret_norm_g[0], gf_c) + ret_readout(flip_seq(oc_b), ret_norm_g[1], gb_c)
    y_ctx = jnp.concatenate([ya_c, yb_c, yc_c, yd_c], axis=-1) @ w_out
    return y_ctx, y_lat


def setup_inputs(seed: int = 0) -> dict:
    key = jax.random.key(seed)
    ks = jax.random.split(key, 24)

    def nrm(k, shape, scale):
        return jax.random.normal(k, shape, jnp.float32) * scale

    a = 5.0 + np.arange(RET_HEADS, dtype=np.float32)
    decay_logit = jnp.asarray(np.log(2.0 ** a - 1.0).astype(np.float32))
    return {
        'x': nrm(ks[0], (BATCH, SEQ, D_MODEL), 1.0),
        'c': nrm(ks[1], (BATCH, D_MODEL), 1.0),
        'ctx': nrm(ks[2], (BATCH, CTX_LEN, D_MODEL), 1.0),
        'c_ctx': nrm(ks[3], (D_MODEL,), 1.0),
        'w_mod': nrm(ks[4], (DEPTH, D_MODEL, N_MOD * D_MODEL), 0.5 * D_MODEL ** -0.5),
        'b_mod': nrm(ks[5], (DEPTH, N_MOD * D_MODEL), 0.02),
        'w_in': nrm(ks[6], (DEPTH, D_MODEL, D_IN), D_MODEL ** -0.5),
        'w_out': nrm(ks[7], (DEPTH, D_MIX, D_MODEL), D_MIX ** -0.5),
        'conv_dw': nrm(ks[8], (DEPTH, CONV_WIDTH, GROUP_W), CONV_WIDTH ** -0.5),
        'conv_b': nrm(ks[9], (DEPTH, GROUP_W), 0.02),
        'conv_ln_g': 1.0 + nrm(ks[10], (DEPTH, GROUP_W), 0.02),
        'conv_ln_b': nrm(ks[11], (DEPTH, GROUP_W), 0.02),
        'conv_pw': nrm(ks[12], (DEPTH, GROUP_W, GROUP_W), GROUP_W ** -0.5),
        'mla_q_g': 1.0 + nrm(ks[13], (DEPTH, MLA_Q_RANK), 0.02),
        'mla_kv_g': 1.0 + nrm(ks[14], (DEPTH, MLA_KV_RANK), 0.02),
        'mla_uq': nrm(ks[15], (DEPTH, MLA_Q_RANK, MLA_HEADS * (MLA_NOPE + MLA_ROPE)), MLA_Q_RANK ** -0.5),
        'mla_ukv': nrm(ks[16], (DEPTH, MLA_KV_RANK, MLA_HEADS * (MLA_NOPE + MLA_V)), MLA_KV_RANK ** -0.5),
        'gqa_q_g': 1.0 + nrm(ks[17], (DEPTH, GQA_HEAD_DIM), 0.02),
        'gqa_k_g': 1.0 + nrm(ks[18], (DEPTH, GQA_HEAD_DIM), 0.02),
        'ret_decay': decay_logit[None, None, :] + nrm(ks[19], (DEPTH, 2, RET_HEADS), 0.1),
        'ret_norm_g': 1.0 + nrm(ks[20], (DEPTH, 2, RET_HEADS, RET_V), 0.02),
        'mlp_w1': nrm(ks[21], (DEPTH, D_MODEL, D_FF), D_MODEL ** -0.5),
        'mlp_w2': nrm(ks[22], (DEPTH, D_FF, D_MODEL), D_FF ** -0.5),
        'final_g': 1.0 + nrm(ks[23], (D_MODEL,), 0.02),
    }


def reference(x, c, ctx, c_ctx, w_mod, b_mod, w_in, w_out, conv_dw, conv_b, conv_ln_g, conv_ln_b,
              conv_pw, mla_q_g, mla_kv_g, mla_uq, mla_ukv, gqa_q_g, gqa_k_g, ret_decay, ret_norm_g,
              mlp_w1, mlp_w2, final_g):
    n_lat = x.shape[1]
    n_rows = n_lat // GRID_W
    row = jnp.repeat(jnp.arange(n_rows, dtype=jnp.int32), GRID_W)
    col = jnp.tile(jnp.arange(GRID_W, dtype=jnp.int32), n_rows)
    pos = (row, col)
    cx = ctx
    for layer in range(DEPTH):
        last = layer == DEPTH - 1
        sh1, sc1, g1, sh2, sc2, g2 = adaln(c, w_mod[layer], b_mod[layer])
        csh1, csc1, cg1, csh2, csc2, cg2 = adaln(c_ctx[None, :], w_mod[layer], b_mod[layer])
        y_ctx, y_lat = mixing_sublayer(
            modulate(cx, csh1, csc1), modulate(x, sh1, sc1), pos, not last,
            w_in[layer], w_out[layer], conv_dw[layer], conv_b[layer], conv_ln_g[layer], conv_ln_b[layer],
            conv_pw[layer], mla_q_g[layer], mla_kv_g[layer], mla_uq[layer], mla_ukv[layer],
            gqa_q_g[layer], gqa_k_g[layer], ret_decay[layer], ret_norm_g[layer])
        x = x + g1 * y_lat
        x = x + g2 * sq_relu_mlp(modulate(x, sh2, sc2), mlp_w1[layer], mlp_w2[layer])
        if not last:
            cx = cx + cg1 * y_ctx
            cx = cx + cg2 * sq_relu_mlp(modulate(cx, csh2, csc2), mlp_w1[layer], mlp_w2[layer])
    return rms_norm(x, final_g)
```

```cpp
#include <hip/hip_runtime.h>
#include <hip/hip_cooperative_groups.h>
#include <cstdio>
#include <cstdint>
namespace cg = cooperative_groups;
#ifndef PROBE_ATT
#define PROBE_ATT 1
#endif
#ifndef PROBE_GEMM
#define PROBE_GEMM 1
#endif
#ifndef PROBE_AUX
#define PROBE_AUX 1
#endif

#define LAS __attribute__((address_space(3)))
typedef unsigned short bf16_t;
typedef short bf16x8 __attribute__((ext_vector_type(8)));
typedef float f32x4 __attribute__((ext_vector_type(4)));
typedef float f32x2 __attribute__((ext_vector_type(2)));
typedef float f32x16 __attribute__((ext_vector_type(16)));
typedef unsigned u32x4 __attribute__((ext_vector_type(4)));
typedef unsigned u32x2 __attribute__((ext_vector_type(2)));

constexpr int NB = 8, SEQ = 4096, DM = 1024, DEPTH = 4, CTX = 256, DIN = 2464, DINP = 2560, DFF = 4096;
constexpr int TL = NB * SEQ, TC = NB * CTX, TT = TL + TC;
constexpr int NMOD = 6 * DM;
constexpr int C_A = 0, C_CQ = 512, C_CKV = 768, C_KPE = 896, C_GQ = 928, C_GK = 1184, C_GV = 1312, C_RQ = 1440, C_RK = 1568, C_RV = 1696, C_GF = 1952, C_GB = 2208;
constexpr float EPS = 1e-6f;
constexpr float LOG2_ROPE = 13.287712379549449f;
constexpr float INV_2PI = 0.15915494309189535f;
constexpr float LOG2E = 1.4426950408889634f;

constexpr size_t MiB = 1u << 20;
constexpr size_t WS_MOD = 0;
constexpr size_t WS_WIN = 1 * MiB;
constexpr size_t WS_WOUT = 6 * MiB;
constexpr size_t WS_W1 = 8 * MiB;
constexpr size_t WS_W2 = 16 * MiB;
constexpr size_t WS_UQ = 24 * MiB;
constexpr size_t WS_UKV = 24 * MiB + 256 * 1024;
constexpr size_t WS_PW = 24 * MiB + 512 * 1024;
constexpr size_t WS_CX = 25 * MiB;
constexpr size_t WS_CKV = 33 * MiB;
constexpr size_t WS_SPT = 51 * MiB;
constexpr size_t WS_XN = 60 * MiB;
constexpr size_t WS_U = 128 * MiB;
constexpr size_t WS_YCAT = 298 * MiB;
constexpr size_t WS_QM = 366 * MiB;
constexpr size_t WS_KVM = 400 * MiB;
constexpr size_t WS_H = 128 * MiB;
constexpr size_t WS_CTL = 434 * MiB;
constexpr size_t CTL_BYTES = 16384;
constexpr size_t WS_NB = WS_CTL + 32 * 1024;
constexpr size_t WS_END = 435 * MiB;

constexpr int LDS_BYTES = 131072 + 2048;

__device__ __forceinline__ unsigned cvt_pk_bf16(float lo, float hi) { unsigned r; asm volatile("v_cvt_pk_bf16_f32 %0, %1, %2" : "=v"(r) : "v"(lo), "v"(hi)); return r; }
__device__ __forceinline__ float bflo(unsigned w) { return __uint_as_float(w << 16); }
__device__ __forceinline__ float bfhi(unsigned w) { return __uint_as_float(w & 0xffff0000u); }
__device__ __forceinline__ float bf1(bf16_t h) { return __uint_as_float(((unsigned)h) << 16); }
__device__ __forceinline__ bf16_t f2bf(float f) { return (bf16_t)(cvt_pk_bf16(f, 0.f) & 0xffffu); }
__device__ __forceinline__ float shx(float v, int o, int lane) { return __int_as_float(__builtin_amdgcn_ds_bpermute((lane ^ o) << 2, __float_as_int(v))); }
__device__ __forceinline__ float wave_sum(float v, int lane) {
#pragma unroll
    for (int o = 1; o < 64; o <<= 1) v += shx(v, o, lane);
    return v;
}
__device__ __forceinline__ float sum16(float v, int lane) {
#pragma unroll
    for (int o = 1; o < 16; o <<= 1) v += shx(v, o, lane);
    return v;
}
__device__ __forceinline__ int crow(int r, int hi) { return (r & 3) + 8 * (r >> 2) + 4 * hi; }
__device__ __forceinline__ float sigmoidf_(float x) { return 1.0f / (1.0f + __expf(-x)); }
__device__ __forceinline__ float fexp2(float x) { return __builtin_amdgcn_exp2f(x); }

namespace pg8 {
constexpr int BM = 256, BK = 64, HALF = 128, HTB = HALF * BK * 2, STAGE_BYTES = 8 * HTB, NXCD = 8, WGM = 8;
__host__ __device__ __forceinline__ int lds_byte(int r, int c) { const int st = (r >> 4) * 2 + (c >> 5), rr = r & 15, cc = c & 31, ob = rr * 64 + cc * 2; return st * 1024 + (ob ^ (((ob >> 9) & 1) << 5)); }
__host__ __device__ __forceinline__ void stage_rc(int b, int& R, int& C) { const int st = b / 1024, sb = b % 1024, swz = sb ^ (((sb >> 9) & 1) << 5); R = (st >> 1) * 16 + swz / 64; C = (st & 1) * 32 + (swz % 64) / 2; }
__host__ __device__ __forceinline__ int perm32(int rho) { const int n = rho >> 4, i = rho & 15; return 8 * (i >> 2) + 4 * n + (i & 3); }

struct Unit { int pm, pn, koff, nt; };
struct Gemm { const bf16_t* A; const bf16_t* Bt; int M, N, K, lda; };

struct StaticOrder {
    int nM, nN, nwg, G, c, ntf, xt0, xnt, xsplit;
    __device__ __forceinline__ void init(int M, int N, int G_, int c_, int K) { nM = M / BM; nN = N / BM; nwg = nM * nN; G = G_; c = c_; ntf = K / BK; xt0 = 0; xnt = 0; xsplit = 1; }
    __device__ __forceinline__ void extra(int first_tile, int ntiles_m, int split) { xt0 = first_tile; xnt = ntiles_m * nN; xsplit = split; }
    __device__ __forceinline__ bool next(int i, Unit& u) const {
        const long L = (long)i * G + c;
        int pm, pn, koff = 0, nt = ntf;
        if (L >= nwg) {
            const int q = (int)(L - nwg); if (q >= xnt * xsplit) return false;
            const int tile = q / xsplit, ks = q % xsplit; pm = xt0 + tile / nN; pn = tile % nN; nt = ntf / xsplit; koff = ks * nt * BK;
        } else {
            int wgid = (int)L; { const int q = nwg / NXCD, r = nwg % NXCD, xcd = wgid % NXCD, off = wgid / NXCD; wgid = (xcd < r ? xcd * (q + 1) : r * (q + 1) + (xcd - r) * q) + off; }
            const int nig = WGM * nN, gid = wgid / nig, fm = gid * WGM, gsz = (nM - fm) < WGM ? (nM - fm) : WGM;
            pm = fm + ((wgid % nig) % gsz); pn = (wgid % nig) / gsz;
        }
        u.pm = pm; u.pn = pn; u.koff = koff; u.nt = nt; return true;
    }
};

template <int ACT  > struct EpiBf16 {
    static constexpr bool PERM = true;
    bf16_t* O; int ldc;
    __device__ __forceinline__ void operator()(const f32x4 (&acc)[2][2][4][2], const Unit& u, int wr, int wc, int fr, int fq) const {
        asm volatile("" : "+v"(fr), "+v"(fq));
        const int row0 = u.pm * BM + wr * 64 + fr; const int col0 = u.pn * BM + wc * 32 + 8 * fq;
#pragma unroll
        for (int ai = 0; ai < 2; ++ai)
#pragma unroll
            for (int m = 0; m < 4; ++m) { bf16_t* rowp = O + (size_t)(row0 + ai * HALF + m * 16) * ldc + col0;
#pragma unroll
                for (int bj = 0; bj < 2; ++bj) { f32x4 v0 = acc[ai][bj][m][0], v1 = acc[ai][bj][m][1];
                    if (ACT == 1) {
#pragma unroll
                        for (int e = 0; e < 4; ++e) { float a = fmaxf(v0[e], 0.f), b = fmaxf(v1[e], 0.f); v0[e] = a * a; v1[e] = b * b; } }
                    u32x4 w; w.x = cvt_pk_bf16(v0[0], v0[1]); w.y = cvt_pk_bf16(v0[2], v0[3]); w.z = cvt_pk_bf16(v1[0], v1[1]); w.w = cvt_pk_bf16(v1[2], v1[3]);
                    *(u32x4*)(rowp + bj * HALF) = w; } }
    }
};
template <int MODE  > struct EpiBf16N {
    static constexpr bool PERM = true;
    bf16_t* O; int ldc; unsigned* nb;
    __device__ __forceinline__ void operator()(const f32x4 (&acc)[2][2][4][2], const Unit& u, int wr, int wc, int fr, int fq) const {
        asm volatile("" : "+v"(fr), "+v"(fq));
        const int row0 = u.pm * BM + wr * 64 + fr; const int col0 = u.pn * BM + wc * 32 + 8 * fq;
        float mxs[2] = {0.f, 0.f};
#pragma unroll
        for (int ai = 0; ai < 2; ++ai)
#pragma unroll
            for (int m = 0; m < 4; ++m) { bf16_t* rowp = O + (size_t)(row0 + ai * HALF + m * 16) * ldc + col0;
#pragma unroll
                for (int bj = 0; bj < 2; ++bj) { const f32x4 v0 = acc[ai][bj][m][0], v1 = acc[ai][bj][m][1];
                    mxs[bj] = fmaxf(mxs[bj], ((v0[0] * v0[0] + v0[1] * v0[1]) + (v0[2] * v0[2] + v0[3] * v0[3])) + ((v1[0] * v1[0] + v1[1] * v1[1]) + (v1[2] * v1[2] + v1[3] * v1[3])));
                    u32x4 w; w.x = cvt_pk_bf16(v0[0], v0[1]); w.y = cvt_pk_bf16(v0[2], v0[3]); w.z = cvt_pk_bf16(v1[0], v1[1]); w.w = cvt_pk_bf16(v1[2], v1[3]);
                    *(u32x4*)(rowp + bj * HALF) = w; } }
        const int ln_ = fq * 16 + fr; const int b = (u.pm >= TL / BM) ? (u.pm - TL / BM) : (u.pm >> 4);
#pragma unroll
        for (int bj = 0; bj < 2; ++bj) {
            float v = mxs[bj];
            v += shx(v, 16, ln_); v += shx(v, 32, ln_);
#pragma unroll
            for (int o = 1; o < 16; o <<= 1) v = fmaxf(v, shx(v, o, ln_));
            const int cidx = 8 * u.pn + 4 * bj + wc;
            int slot = -1;
            if (MODE == 0) { if (cidx < 12) slot = (b * 4 + cidx / 3) * 3 + cidx % 3; }
            else { if ((cidx & 3) < 2) slot = 96 + (b * 4 + (cidx >> 2)) * 2 + (cidx & 3); }
            if (slot >= 0 && ln_ == 0) atomicMax(nb + slot, __float_as_uint(v * 1.02f));
        }
    }
};
struct EpiRes {
    static constexpr bool PERM = false;
    const float* base_lat; const float* base_ctx; float* out_lat; float* out_ctx; const float* gate;
    float* part;
    __device__ __forceinline__ void operator()(const f32x4 (&acc)[2][2][4][2], const Unit& u, int wr, int wc, int fr, int fq) const {
        asm volatile("" : "+v"(fr), "+v"(fq));
        const bool isctx = u.pm >= (TL / BM); const int j = isctx ? 8 : (u.pm >> 4);
        if (part && isctx) {
            const int ks = u.koff / (u.nt * BK);
            float* pp = part + ((size_t)ks * TC + (size_t)(u.pm - TL / BM) * BM) * DM + u.pn * BM + wc * 32 + 4 * fq;
#pragma unroll
            for (int ai = 0; ai < 2; ++ai)
#pragma unroll
                for (int m = 0; m < 4; ++m) { float* rp = pp + (size_t)(ai * HALF + wr * 64 + m * 16 + fr) * DM;
#pragma unroll
                    for (int bj = 0; bj < 2; ++bj)
#pragma unroll
                        for (int n = 0; n < 2; ++n) *(f32x4*)(rp + bj * HALF + n * 16) = acc[ai][bj][m][n]; }
            return;
        }
        const float* base = isctx ? base_ctx : base_lat; float* out = isctx ? out_ctx : out_lat;
        const int prow = isctx ? (u.pm - TL / BM) * BM : u.pm * BM;
        const float* g = gate + (size_t)j * NMOD;
        const int col0 = u.pn * BM + wc * 32 + 4 * fq;
        f32x4 gv[2][2];
#pragma unroll
        for (int bj = 0; bj < 2; ++bj)
#pragma unroll
            for (int n = 0; n < 2; ++n) gv[bj][n] = *(const f32x4*)(g + col0 + bj * HALF + n * 16);
#pragma unroll
        for (int ai = 0; ai < 2; ++ai) {
            f32x4 bs[4][2][2];
#pragma unroll
            for (int m = 0; m < 4; ++m) { const size_t off = (size_t)(prow + ai * HALF + wr * 64 + m * 16 + fr) * DM + col0;
#pragma unroll
                for (int bj = 0; bj < 2; ++bj)
#pragma unroll
                    for (int n = 0; n < 2; ++n) bs[m][bj][n] = *(const f32x4*)(base + off + bj * HALF + n * 16); }
            __builtin_amdgcn_sched_barrier(0);
#pragma unroll
            for (int m = 0; m < 4; ++m) { const size_t off = (size_t)(prow + ai * HALF + wr * 64 + m * 16 + fr) * DM + col0;
#pragma unroll
                for (int bj = 0; bj < 2; ++bj)
#pragma unroll
                    for (int n = 0; n < 2; ++n) *(f32x4*)(out + off + bj * HALF + n * 16) = bs[m][bj][n] + gv[bj][n] * acc[ai][bj][m][n]; }
            __builtin_amdgcn_sched_barrier(0);
        }
    }
};

template <class Epi, class Sched, bool ALIGN_EPI = true>
__device__ __forceinline__ void gemm_phase(LAS unsigned char* lds, const Gemm g, const Sched& S, const Epi& E, const int tid) {
    const int wid = __builtin_amdgcn_readfirstlane(tid >> 6), lane = tid & 63, wr = wid >> 2, wc = wid & 3, fr = lane & 15, fq = lane >> 4;
    const int K = g.K, lda = g.lda;
    unsigned voffA[2], voffB[2];
#define PG8_VOFFS(T_) do { _Pragma("unroll") for (int i = 0; i < 2; ++i) { int R, C; stage_rc((T_) * 16 + i * 8192, R, C); const int Rb = Epi::PERM ? ((R & ~31) + perm32(R & 31)) : R; \
        voffA[i] = (unsigned)(R * lda + C) * 2u; voffB[i] = (unsigned)(Rb * K + C) * 2u; } } while (0)
    PG8_VOFFS(tid);
    const size_t kstep = (size_t)(BK * 2);
    const size_t hstepA = (size_t)HALF * lda * 2, hstepB = (size_t)HALF * K * 2;
    const size_t tstepA = 2 * hstepA, tstepB = 2 * hstepB;
    const unsigned ldsw = (unsigned)wid * 1024u;
    int aoff = lds_byte(wr * 64 + fr, fq * 8), boff = lds_byte(wc * 32 + fr, fq * 8);
#define PG8_SA(b, h) (((b) * 2 + (h)) * HTB)
#define PG8_SB(b, h) ((4 + (b) * 2 + (h)) * HTB)
#define PG8_STAGE(bufoff, gbase, voff) do { _Pragma("unroll") for (int _i = 0; _i < 2; ++_i) \
        __builtin_amdgcn_global_load_lds((const unsigned*)((const char*)(gbase) + (voff)[_i]), (LAS unsigned*)(lds + (bufoff) + ldsw + _i * 8192), 16, 0, 0); } while (0)
#define PG8_LDA(dst, b, h) do { _Pragma("unroll") for (int m = 0; m < 4; ++m) _Pragma("unroll") for (int k = 0; k < 2; ++k) dst[m][k] = *(const LAS bf16x8*)(lds + PG8_SA(b, h) + aoff + m * 2048 + k * 1024); } while (0)
#define PG8_LDB(dst, b, h) do { _Pragma("unroll") for (int n = 0; n < 2; ++n) _Pragma("unroll") for (int k = 0; k < 2; ++k) dst[n][k] = *(const LAS bf16x8*)(lds + PG8_SB(b, h) + boff + n * 2048 + k * 1024); } while (0)
#define PG8_MMA(ai, bj, At, Bt) do { __builtin_amdgcn_s_setprio(1); _Pragma("unroll") for (int m = 0; m < 4; ++m) _Pragma("unroll") for (int n = 0; n < 2; ++n) _Pragma("unroll") for (int k = 0; k < 2; ++k) \
        acc[ai][bj][m][n] = __builtin_amdgcn_mfma_f32_16x16x32_bf16(Bt[n][k], At[m][k], acc[ai][bj][m][n], 0, 0, 0); __builtin_amdgcn_s_setprio(0); } while (0)
#define PG8_WAIT_V(n) asm volatile("s_waitcnt vmcnt(" #n ")" ::: "memory")
#define PG8_WAIT_L(n) asm volatile("s_waitcnt lgkmcnt(" #n ")" ::: "memory")
#define PG8_BAR __builtin_amdgcn_s_barrier()
#define PG8_SCHED __builtin_amdgcn_sched_barrier(0)
    Unit cur, nxt; int ui = 0;
    if (!S.next(0, cur)) return;
    f32x4 acc[2][2][4][2];
#pragma unroll
    for (int a = 0; a < 2; ++a)
#pragma unroll
        for (int b = 0; b < 2; ++b)
#pragma unroll
            for (int m = 0; m < 4; ++m)
#pragma unroll
                for (int n = 0; n < 2; ++n) acc[a][b][m][n] = (f32x4){0.f, 0.f, 0.f, 0.f};
    bf16x8 At[4][2], B0[2][2], B1[2][2];
    const char* cA = (const char*)g.A + (size_t)cur.pm * tstepA + (size_t)cur.koff * 2; const char* cB = (const char*)g.Bt + (size_t)cur.pn * tstepB + (size_t)cur.koff * 2;
    PG8_STAGE(PG8_SB(0, 0), cB, voffB); PG8_STAGE(PG8_SB(0, 1), cB + hstepB, voffB); PG8_STAGE(PG8_SA(0, 0), cA, voffA); PG8_STAGE(PG8_SA(0, 1), cA + hstepA, voffA);
    if (wr == 1) PG8_BAR;
    PG8_WAIT_V(2); PG8_BAR;
    PG8_STAGE(PG8_SB(1, 0), cB + kstep, voffB); PG8_STAGE(PG8_SA(1, 0), cA + kstep, voffA); PG8_STAGE(PG8_SB(1, 1), cB + hstepB + kstep, voffB);
    PG8_WAIT_V(6); PG8_BAR;
    for (;;) {
        const bool has_next = S.next(ui + 1, nxt);
        const char* nA = has_next ? (const char*)g.A + (size_t)nxt.pm * tstepA + (size_t)nxt.koff * 2 : cA; const char* nB = has_next ? (const char*)g.Bt + (size_t)nxt.pn * tstepB + (size_t)nxt.koff * 2 : cB;
        const int nt = cur.nt;
        for (int t = 0; t < nt; t += 2) {
            const bool last = (t == nt - 2);
            const char* a1 = cA + (size_t)(t + 1) * kstep;
            const char* a2 = last ? nA : cA + (size_t)(t + 2) * kstep; const char* b2 = last ? nB : cB + (size_t)(t + 2) * kstep;
            const char* a3 = a2 + kstep; const char* b3 = b2 + kstep;
            PG8_LDB(B0, 0, 0); PG8_LDB(B1, 0, 1); PG8_SCHED; PG8_LDA(At, 0, 0); PG8_STAGE(PG8_SA(1, 1), a1 + hstepA, voffA);
            PG8_WAIT_V(8); PG8_WAIT_L(0); PG8_BAR; PG8_MMA(0, 0, At, B0); PG8_MMA(0, 1, At, B1); PG8_BAR; PG8_SCHED;
            PG8_LDA(At, 0, 1); PG8_STAGE(PG8_SB(0, 0), b2, voffB); PG8_STAGE(PG8_SB(0, 1), b2 + hstepB, voffB); PG8_STAGE(PG8_SA(0, 0), a2, voffA);
            PG8_WAIT_V(8); PG8_WAIT_L(0); PG8_BAR; PG8_MMA(1, 0, At, B0); PG8_MMA(1, 1, At, B1); PG8_BAR; PG8_SCHED;
            PG8_LDB(B0, 1, 0); PG8_LDB(B1, 1, 1); PG8_SCHED; PG8_LDA(At, 1, 0); PG8_STAGE(PG8_SA(0, 1), a2 + hstepA, voffA);
            PG8_WAIT_V(8); PG8_WAIT_L(0); PG8_BAR; PG8_MMA(0, 0, At, B0); PG8_MMA(0, 1, At, B1); PG8_BAR; PG8_SCHED;
            PG8_LDA(At, 1, 1); PG8_STAGE(PG8_SB(1, 0), b3, voffB); PG8_STAGE(PG8_SB(1, 1), b3 + hstepB, voffB); PG8_STAGE(PG8_SA(1, 0), a3, voffA);
            PG8_WAIT_V(8); PG8_WAIT_L(0); PG8_BAR; PG8_MMA(1, 0, At, B0); PG8_MMA(1, 1, At, B1); PG8_BAR; PG8_SCHED;
        }
        if constexpr (ALIGN_EPI) { if (wr == 0) PG8_BAR; }
        E(acc, cur, wr, wc, fr, fq);
        if (!has_next) break;
#pragma unroll
        for (int a = 0; a < 2; ++a)
#pragma unroll
            for (int b = 0; b < 2; ++b)
#pragma unroll
                for (int m = 0; m < 4; ++m)
#pragma unroll
                    for (int n = 0; n < 2; ++n) acc[a][b][m][n] = (f32x4){0.f, 0.f, 0.f, 0.f};
        cur = nxt; cA = nA; cB = nB; ++ui;
        { int l2; asm volatile("v_mbcnt_lo_u32_b32 %0, -1, 0\n\tv_mbcnt_hi_u32_b32 %0, -1, %0" : "=v"(l2)); const int t2 = wid * 64 + l2; PG8_VOFFS(t2); const int fr2 = l2 & 15, fq2 = l2 >> 4; aoff = lds_byte(wr * 64 + fr2, fq2 * 8); boff = lds_byte(wc * 32 + fr2, fq2 * 8); }
        if constexpr (ALIGN_EPI) { if (wr == 1) PG8_BAR; }
    }
    PG8_WAIT_V(0);
    if constexpr (!ALIGN_EPI) { if (wr == 0) PG8_BAR; }
    PG8_BAR;
#undef PG8_SA
#undef PG8_SB
#undef PG8_STAGE
#undef PG8_LDA
#undef PG8_LDB
#undef PG8_MMA
#undef PG8_WAIT_V
#undef PG8_WAIT_L
#undef PG8_BAR
#undef PG8_SCHED
#undef PG8_VOFFS
}
}


#define XB_TMO      128
#define XB_XCNT(j)  (256  + 64 * (j))
#define XB_XSUB(j)  (1280 + 64 * (j))
#define XB_XGEN(j)  (2304 + 64 * (j))
#define XB_TOP      3328
#define XB_TOPGEN   3392
#define XCD_BAR_WORDS 3456
#define XB_SPIN_CAP (1u << 22)
__device__ __forceinline__ unsigned xb_ld(unsigned* p)              { return __hip_atomic_load(p, __ATOMIC_RELAXED, __HIP_MEMORY_SCOPE_AGENT); }
__device__ __forceinline__ unsigned xb_add(unsigned* p, unsigned v) { return __hip_atomic_fetch_add(p, v, __ATOMIC_RELAXED, __HIP_MEMORY_SCOPE_AGENT); }
__device__ __forceinline__ unsigned xb_xcc_id() { return (unsigned)__builtin_amdgcn_s_getreg((3 << 11) | 20) & 0xFu; }
#define XB_SPIN(cond, bar) do { unsigned _sp = 0; while (cond) { __builtin_amdgcn_s_sleep(1); \
    if ((++_sp & 255u) == 0u) { if (xb_ld(&(bar)[XB_TMO])) break; if (_sp > XB_SPIN_CAP) { atomicAdd(&(bar)[XB_TMO], 1u); break; } } } } while (0)
struct XcdBarrier { unsigned* bar; unsigned x; volatile LAS unsigned* st; };
__device__ __forceinline__ void xcd_barrier_complete(unsigned* bar, unsigned x, unsigned& nloc, unsigned& nx) {
    const unsigned G = gridDim.x * gridDim.y * gridDim.z;
    unsigned sum, cnt, mine, sp = 0u;
    for (;;) {
        sum = 0u; cnt = 0u; mine = 0u;
#pragma unroll
        for (unsigned j = 0; j < 16; ++j) { const unsigned c = xb_ld(&bar[XB_XCNT(j)]); sum += c; cnt += (c > 0u) ? 1u : 0u; mine = (j == x) ? c : mine; }
        if (sum == G) break;
        __builtin_amdgcn_s_sleep(1);
        if ((++sp & 255u) == 0u) { if (xb_ld(&bar[XB_TMO])) break; if (sp > XB_SPIN_CAP) { atomicAdd(&bar[XB_TMO], 1u); break; } }
    }
    nloc = mine > 0u ? mine : 1u; nx = cnt > 0u ? cnt : 1u;
}
__device__ __forceinline__ void xcd_barrier(const XcdBarrier& b, bool t0) {
    asm volatile("s_waitcnt vmcnt(0)" ::: "memory");
    __syncthreads();
    if (t0) {
        unsigned* bar = b.bar;
        __builtin_amdgcn_s_waitcnt(0);
        unsigned nloc = b.st[0], nx = b.st[1];
        if (nloc == 0u) { xcd_barrier_complete(bar, b.x, nloc, nx); b.st[0] = nloc; b.st[1] = nx; }
        const unsigned old = xb_add(&bar[XB_XSUB(b.x)], 1u);
        const unsigned gen = old / nloc;
        if (old + 1u == (gen + 1u) * nloc) {
            __builtin_amdgcn_fence(__ATOMIC_RELEASE, "agent");
            asm volatile("s_waitcnt vmcnt(0)" ::: "memory");
            const unsigned og = xb_add(&bar[XB_TOP], 1u);
            const unsigned tg = og / nx;
            if (og + 1u == (tg + 1u) * nx) xb_add(&bar[XB_TOPGEN], 1u);
            else XB_SPIN(xb_ld(&bar[XB_TOPGEN]) == tg, bar);
            __builtin_amdgcn_fence(__ATOMIC_ACQUIRE, "agent");
            xb_add(&bar[XB_XGEN(b.x)], 1u);
            asm volatile("s_waitcnt vmcnt(0)" ::: "memory");
        } else {
            XB_SPIN(xb_ld(&bar[XB_XGEN(b.x)]) == gen, bar);
            __builtin_amdgcn_fence(__ATOMIC_ACQUIRE, "agent");
            asm volatile("s_waitcnt vmcnt(0)" ::: "memory");
        }
    }
    __syncthreads();
}

struct Args { const float* in[24]; float* out; unsigned char* ws; };
enum { I_X = 0, I_C, I_CTX, I_CCTX, I_WMOD, I_BMOD, I_WIN, I_WOUT, I_CDW, I_CB, I_CLG, I_CLB, I_CPW, I_MQG, I_MKVG, I_MUQ, I_MUKV, I_GQG, I_GKG, I_RDEC, I_RNG, I_W1, I_W2, I_FG };

__device__ __forceinline__ void transpose_item(const float* W, int K, int N, bf16_t* WT, LAS float* scr, int item, int lane) {
    const int nblk = N / 32, kb = item / nblk, nb = item % nblk, k0 = 64 * kb, n0 = 32 * nb;
#pragma unroll 8
    for (int i = 0; i < 32; ++i) { const int kk = 2 * i + (lane >> 5); scr[kk * 33 + (lane & 31)] = W[(size_t)(k0 + kk) * N + n0 + (lane & 31)]; }
    asm volatile("s_waitcnt lgkmcnt(0)" ::: "memory");
    const int c = lane & 7;
#pragma unroll
    for (int j = 0; j < 4; ++j) { const int n = (lane >> 3) + 8 * j; const LAS float* s = scr + (8 * c) * 33 + n;
        u32x4 o; o.x = cvt_pk_bf16(s[0 * 33], s[1 * 33]); o.y = cvt_pk_bf16(s[2 * 33], s[3 * 33]); o.z = cvt_pk_bf16(s[4 * 33], s[5 * 33]); o.w = cvt_pk_bf16(s[6 * 33], s[7 * 33]);
        *(u32x4*)(WT + (size_t)(n0 + n) * K + k0 + 8 * c) = o; }
    asm volatile("s_waitcnt lgkmcnt(0)" ::: "memory");
}

__device__ __forceinline__ void norm_row_mod(const float* xrow, const float* sh, const float* sc, bf16_t* orow, int lane) {
    const f32x4* xr = (const f32x4*)xrow + lane;
    f32x4 v[4]; float s = 0.f;
#pragma unroll
    for (int j = 0; j < 4; ++j) { v[j] = xr[64 * j]; s += (v[j].x * v[j].x + v[j].y * v[j].y) + (v[j].z * v[j].z + v[j].w * v[j].w); }
    const float rstd = rsqrtf(wave_sum(s, lane) * (1.f / DM) + EPS);
    u32x2* o8 = (u32x2*)orow + lane;
#pragma unroll
    for (int j = 0; j < 4; ++j) { const f32x4 a = ((const f32x4*)sh)[lane + 64 * j], b = ((const f32x4*)sc)[lane + 64 * j];
        const f32x4 y = v[j] * rstd * (b + 1.0f) + a;
        u32x2 w; w.x = cvt_pk_bf16(y.x, y.y); w.y = cvt_pk_bf16(y.z, y.w); o8[64 * j] = w; }
}

typedef short v4i16_t __attribute__((ext_vector_type(4)));
__device__ __forceinline__ v4i16_t vtr(const LAS unsigned char* p) { return __builtin_amdgcn_ds_read_tr16_b64_v4i16((LAS v4i16_t*)p); }
template <int DQ, bool NOMAX>
__device__ __forceinline__ void attn_unit(LAS unsigned char* lds, const bf16_t* Qp, int ldq, const bf16_t* Kp, int ldk, const bf16_t* Kx, const bf16_t* Vp, int ldv,
                                          bf16_t* Op, int qrow0, int qpos0, int nkt, int kseg0_row, int kseg1_row, bool rope, float C_, const int tid) {
    float C = C_; asm volatile("" : "+v"(C));
    constexpr int KST = DQ * 2 + 16, BUFSZ = 64 * KST + 8192, NS = DQ / 16;
    const int lane = tid & 63, wave = __builtin_amdgcn_readfirstlane(tid >> 6), li = lane & 31, hi = lane >> 5;
    f32x16 O0, O1;
#pragma unroll
    for (int r = 0; r < 16; ++r) { O0[r] = 0.f; O1[r] = 0.f; }
    float mrun = -INFINITY, lrun = 0.f;
    const int skey = tid >> 3, sch = tid & 7;
    const int xkey = tid >> 3, xch = tid & 7;
    const int kwoff = skey * KST + sch * 16, xwoff = xkey * KST + 128 + xch * 8;
    const int vwoff = 64 * KST + (skey >> 2) * 512 + (sch >> 2) * 256 + (skey & 3) * 64 + (sch & 3) * 16;
    const int aoff = li * KST + hi * 16;
    const int vroff = 64 * KST + hi * 512 + ((lane & 15) >> 2) * 64 + ((lane >> 4) & 1) * 32 + (lane & 3) * 8;
    u32x4 kregA, vregA, kregB, vregB; u32x2 xregA, xregB;
#define ATT_GLOAD(t, KR, VR, XR) do { const int row_ = ((t) < 4 ? kseg0_row + 64 * (t) : kseg1_row + 64 * ((t) - 4)); \
        KR = *(const u32x4*)(Kp + (size_t)(row_ + skey) * ldk + 8 * sch); \
        VR = *(const u32x4*)(Vp + (size_t)(row_ + skey) * ldv + 8 * sch); \
        if constexpr (DQ == 96) { XR = *(const u32x2*)(Kx + (size_t)(row_ + xkey) * DINP + 4 * xch); } } while (0)
#define ATT_LSTORE(buf, KR, VR, XR) do { LAS unsigned char* B_ = lds + (buf) * BUFSZ; \
        *(LAS u32x4*)(B_ + kwoff) = KR; *(LAS u32x4*)(B_ + vwoff) = VR; \
        if constexpr (DQ == 96) { *(LAS u32x2*)(B_ + xwoff) = XR; } } while (0)
#define ATT_TILE(t, LK, LV, LX, SK, SV, SX) do { \
        if ((t) + 2 < nkt) ATT_GLOAD((t) + 2, LK, LV, LX); \
        const LAS unsigned char* Bb = lds + ((t) & 1) * BUFSZ; \
        bf16x8 kf0[NS], kf1[NS]; \
        _Pragma("unroll") for (int s = 0; s < NS; ++s) { kf0[s] = *(const LAS bf16x8*)(Bb + aoff + s * 32); kf1[s] = *(const LAS bf16x8*)(Bb + 32 * KST + aoff + s * 32); } \
        v4i16_t vl0[4], vh0[4], vl1[4], vh1[4]; \
        if constexpr (DQ == 64) { _Pragma("unroll") for (int ks = 0; ks < 4; ++ks) { const LAS unsigned char* vb = Bb + vroff + ks * 2048; vl0[ks] = vtr(vb); vh0[ks] = vtr(vb + 1024); vl1[ks] = vtr(vb + 256); vh1[ks] = vtr(vb + 1024 + 256); } } \
        __builtin_amdgcn_sched_barrier(0); \
        f32x16 S0, S1; \
        _Pragma("unroll") for (int r = 0; r < 16; ++r) { S0[r] = 0.f; S1[r] = 0.f; } \
        _Pragma("unroll") for (int s = 0; s < NS; ++s) { \
            S0 = __builtin_amdgcn_mfma_f32_32x32x16_bf16(kf0[s], qf[s], S0, 0, 0, 0); \
            S1 = __builtin_amdgcn_mfma_f32_32x32x16_bf16(kf1[s], qf[s], S1, 0, 0, 0); } \
        float ls0 = 0.f, ls1 = 0.f; \
        if constexpr (NOMAX) {     \
            _Pragma("unroll") for (int r = 0; r < 16; ++r) { S0[r] = fexp2(S0[r]); S1[r] = fexp2(S1[r]); ls0 += S0[r]; ls1 += S1[r]; } \
        } else { \
        float mxa = fmaxf(S0[0], S1[0]), mxb = fmaxf(S0[1], S1[1]); \
        _Pragma("unroll") for (int r = 2; r < 16; r += 2) { mxa = fmaxf(fmaxf(mxa, S0[r]), S1[r]); mxb = fmaxf(fmaxf(mxb, S0[r + 1]), S1[r + 1]); }     \
        float mx = fmaxf(mxa, mxb); \
        mx = fmaxf(mx, shx(mx, 32, lane)); \
        if (__builtin_amdgcn_ballot_w64(mx > mrun) != 0ull) { \
            const float mnew = fmaxf(mrun, mx); \
            const float alpha = fexp2((mrun - mnew) * C); \
            mrun = mnew; lrun *= alpha; \
            _Pragma("unroll") for (int r = 0; r < 16; ++r) { O0[r] *= alpha; O1[r] *= alpha; } } \
        const float mc = mrun * C; \
        _Pragma("unroll") for (int r = 0; r < 16; ++r) { S0[r] = fexp2(S0[r] * C - mc); S1[r] = fexp2(S1[r] * C - mc); ls0 += S0[r]; ls1 += S1[r]; } \
        } \
        lrun += ls0 + ls1; \
        if constexpr (DQ != 64) { __builtin_amdgcn_sched_barrier(0); _Pragma("unroll") for (int ks = 0; ks < 4; ++ks) { const LAS unsigned char* vb = Bb + vroff + ks * 2048; vl0[ks] = vtr(vb); vh0[ks] = vtr(vb + 1024); vl1[ks] = vtr(vb + 256); vh1[ks] = vtr(vb + 1024 + 256); } } \
        bf16x8 pb[4]; \
        _Pragma("unroll") for (int e = 0; e < 2; ++e) { u32x4 w0, w1; \
            w0.x = cvt_pk_bf16(S0[8 * e + 0], S0[8 * e + 1]); w0.y = cvt_pk_bf16(S0[8 * e + 2], S0[8 * e + 3]); w0.z = cvt_pk_bf16(S0[8 * e + 4], S0[8 * e + 5]); w0.w = cvt_pk_bf16(S0[8 * e + 6], S0[8 * e + 7]); \
            w1.x = cvt_pk_bf16(S1[8 * e + 0], S1[8 * e + 1]); w1.y = cvt_pk_bf16(S1[8 * e + 2], S1[8 * e + 3]); w1.z = cvt_pk_bf16(S1[8 * e + 4], S1[8 * e + 5]); w1.w = cvt_pk_bf16(S1[8 * e + 6], S1[8 * e + 7]); \
            pb[e] = __builtin_bit_cast(bf16x8, w0); pb[2 + e] = __builtin_bit_cast(bf16x8, w1); } \
        _Pragma("unroll") for (int ks = 0; ks < 4; ++ks) { \
            const bf16x8 a0 = __builtin_shufflevector(vl0[ks], vh0[ks], 0, 1, 2, 3, 4, 5, 6, 7), a1 = __builtin_shufflevector(vl1[ks], vh1[ks], 0, 1, 2, 3, 4, 5, 6, 7); \
            O0 = __builtin_amdgcn_mfma_f32_32x32x16_bf16(a0, pb[ks], O0, 0, 0, 0); \
            O1 = __builtin_amdgcn_mfma_f32_32x32x16_bf16(a1, pb[ks], O1, 0, 0, 0); } \
        if ((t) + 1 < nkt) ATT_LSTORE(((t) + 1) & 1, SK, SV, SX); \
        __syncthreads(); } while (0)
    ATT_GLOAD(0, kregA, vregA, xregA); ATT_GLOAD(1, kregB, vregB, xregB);
    bf16x8 qf[NS];
    {
        const bf16_t* qrow = Qp + (size_t)(qrow0 + wave * 32 + li) * ldq;
#pragma unroll
        for (int s = 0; s < 4; ++s) qf[s] = *(const bf16x8*)(qrow + 16 * s + 8 * hi);
        if constexpr (DQ == 96 && NOMAX) {
#pragma unroll
            for (int s = 0; s < 4; ++s) { const u32x4 a = __builtin_bit_cast(u32x4, qf[s]); u32x4 w;
                w.x = cvt_pk_bf16(bflo(a.x) * C_, bfhi(a.x) * C_); w.y = cvt_pk_bf16(bflo(a.y) * C_, bfhi(a.y) * C_); w.z = cvt_pk_bf16(bflo(a.z) * C_, bfhi(a.z) * C_); w.w = cvt_pk_bf16(bflo(a.w) * C_, bfhi(a.w) * C_);
                qf[s] = __builtin_bit_cast(bf16x8, w); }
        }
        if constexpr (DQ == 96) {
            const int t = qpos0 + wave * 32 + li;
#pragma unroll
            for (int s = 4; s < 6; ++s) {
                const u32x4 a = *(const u32x4*)(qrow + 16 * s), b = *(const u32x4*)(qrow + 16 * s + 8);
                float x1[8] = {bflo(a.x), bfhi(a.x), bflo(a.y), bfhi(a.y), bflo(a.z), bfhi(a.z), bflo(a.w), bfhi(a.w)};
                float x2[8] = {bflo(b.x), bfhi(b.x), bflo(b.y), bfhi(b.y), bflo(b.z), bfhi(b.z), bflo(b.w), bfhi(b.w)};
                float y[8];
                const float pos = (float)(s == 4 ? (t >> 6) : (t & 63));
#pragma unroll
                for (int i = 0; i < 8; ++i) {
                    float cs = 1.f, sn = 0.f;
                    if (rope) { const float rev = pos * fexp2(-(float)i * (LOG2_ROPE / 8.f)) * INV_2PI; cs = __builtin_amdgcn_cosf(rev); sn = __builtin_amdgcn_sinf(rev); }
                    y[i] = hi ? (x1[i] * sn + x2[i] * cs) : (x1[i] * cs - x2[i] * sn);
                    if constexpr (NOMAX) y[i] *= C_;
                }
                u32x4 w; w.x = cvt_pk_bf16(y[0], y[1]); w.y = cvt_pk_bf16(y[2], y[3]); w.z = cvt_pk_bf16(y[4], y[5]); w.w = cvt_pk_bf16(y[6], y[7]);
                qf[s] = __builtin_bit_cast(bf16x8, w);
            }
        }
    }
    ATT_LSTORE(0, kregA, vregA, xregA);
    __syncthreads();
    for (int t = 0; t < nkt; t += 2) {
        ATT_TILE(t, kregA, vregA, xregA, kregB, vregB, xregB);
        ATT_TILE(t + 1, kregB, vregB, xregB, kregA, vregA, xregA);
    }
#undef ATT_TILE
#undef ATT_GLOAD
#undef ATT_LSTORE
    const float ltot = lrun + shx(lrun, 32, lane);
    const float rl = 1.0f / ltot;
    bf16_t* orow = Op + (size_t)(qrow0 + wave * 32 + li) * DM;
#pragma unroll
    for (int rg = 0; rg < 4; ++rg) {
        u32x2 w0, w1;
        w0.x = cvt_pk_bf16(O0[4 * rg] * rl, O0[4 * rg + 1] * rl); w0.y = cvt_pk_bf16(O0[4 * rg + 2] * rl, O0[4 * rg + 3] * rl);
        w1.x = cvt_pk_bf16(O1[4 * rg] * rl, O1[4 * rg + 1] * rl); w1.y = cvt_pk_bf16(O1[4 * rg + 2] * rl, O1[4 * rg + 3] * rl);
        *(u32x2*)(orow + 8 * rg + 4 * hi) = w0;
        *(u32x2*)(orow + 32 + 8 * rg + 4 * hi) = w1;
    }
}

__global__ void __launch_bounds__(512, 2) mega_fwd(Args a) {
    extern __shared__ __attribute__((aligned(16))) unsigned char lds_raw[];
    LAS unsigned char* lds = (LAS unsigned char*)lds_raw;
    cg::grid_group grid = cg::this_grid();
    const int G = gridDim.x; int bid = blockIdx.x;
    const int NGW = G * 8;
    const int wave0 = __builtin_amdgcn_readfirstlane((int)threadIdx.x >> 6);
    volatile LAS unsigned* bst = (volatile LAS unsigned*)(lds + 131072 + 64);
    if (threadIdx.x < 4) bst[threadIdx.x] = 0u;
    __syncthreads();
    XcdBarrier xbar; xbar.bar = (unsigned*)(a.ws + WS_CTL); xbar.x = xb_xcc_id(); xbar.st = bst;
    if (blockIdx.x == 0) { for (int i = threadIdx.x; i < (int)(CTL_BYTES / 4); i += 512) __hip_atomic_store(xbar.bar + i, 0u, __ATOMIC_RELAXED, __HIP_MEMORY_SCOPE_AGENT); }
    const bool thr0 = (threadIdx.x == 0);
#define GRID_BAR() xcd_barrier(xbar, thr0)
#define PHASE_IDS() int lane_; asm volatile("v_mbcnt_lo_u32_b32 %0, -1, 0\n\tv_mbcnt_hi_u32_b32 %0, -1, %0" : "=v"(lane_)); const int lane = lane_; const int wave = wave0; const int tid = wave * 64 + lane; const int gw = bid * 8 + wave; (void)lane; (void)gw; (void)tid; \
    const AS4 char* kp_ = (const AS4 char*)__builtin_amdgcn_kernarg_segment_ptr(); asm volatile("" : "+s"(kp_)); unsigned char* const ws = *(unsigned char* const AS4*)(kp_ + 200); (void)ws;
#define AS4 __attribute__((address_space(4)))
#define IN(i) (*(const float* const AS4*)(kp_ + 8 * (i)))
#define OUTP (*(float* const AS4*)(kp_ + 192))
#define MOD ((float*)(ws + WS_MOD))
#define WINT ((bf16_t*)(ws + WS_WIN))
#define WOUTT ((bf16_t*)(ws + WS_WOUT))
#define W1T ((bf16_t*)(ws + WS_W1))
#define W2T ((bf16_t*)(ws + WS_W2))
#define UQT ((bf16_t*)(ws + WS_UQ))
#define UKVT ((bf16_t*)(ws + WS_UKV))
#define PWT ((bf16_t*)(ws + WS_PW))
#define CX ((float*)(ws + WS_CX))
#define CKV ((float*)(ws + WS_CKV))
#define SPT ((bf16_t*)(ws + WS_SPT))
#define XN ((bf16_t*)(ws + WS_XN))
#define CA ((bf16_t*)(ws + WS_XN))
#define U ((bf16_t*)(ws + WS_U))
#define YCAT ((bf16_t*)(ws + WS_YCAT))
#define QM ((bf16_t*)(ws + WS_QM))
#define KVM ((bf16_t*)(ws + WS_KVM))
#define HB ((bf16_t*)(ws + WS_H))
#define modl (MOD + (size_t)l * 9 * NMOD)
#define xlat_in ((l == 0) ? IN(I_X) : OUTP)
#define xctx_in ((l == 0) ? IN(I_CTX) : CX)

    {
        PHASE_IDS();
        LAS float* sc = (LAS float*)lds;
        LAS float* red = sc + 9 * 1024;
        for (int i = tid; i < 9 * 1024; i += 512) { const float v = (i < 8192) ? IN(I_C)[i] : IN(I_CCTX)[i - 8192]; sc[i] = v * sigmoidf_(v); }
        if (bid == 0 && tid < DEPTH * 8) { const float dd = IN(I_RDEC)[tid]; MOD[DEPTH * 9 * NMOD + tid] = -log1pf(__expf(-dd)) * LOG2E; }
        __syncthreads();
        for (int item = bid; item < DEPTH * 48; item += G) {
            const int l = item / 48, n0 = (item % 48) * 128;
            const float* W = IN(I_WMOD) + (size_t)l * DM * NMOD + n0 + lane * 2;
            float acc[9][2];
#pragma unroll
            for (int j = 0; j < 9; ++j) { acc[j][0] = 0.f; acc[j][1] = 0.f; }
            for (int kk = 0; kk < 128; ++kk) {
                const int k = wave * 128 + kk; const f32x2 w = *(const f32x2*)(W + (size_t)k * NMOD);
#pragma unroll
                for (int j = 0; j < 9; ++j) { const float s = sc[j * 1024 + k]; acc[j][0] += s * w.x; acc[j][1] += s * w.y; }
            }
#pragma unroll
            for (int j = 0; j < 9; ++j) { red[(wave * 18 + j * 2) * 64 + lane] = acc[j][0]; red[(wave * 18 + j * 2 + 1) * 64 + lane] = acc[j][1]; }
            __syncthreads();
            for (int o = tid; o < 18 * 64; o += 512) {
                const int aidx = o >> 6, ln = o & 63; float s = 0.f;
#pragma unroll
                for (int w = 0; w < 8; ++w) s += red[(w * 18 + aidx) * 64 + ln];
                const int j = aidx >> 1, n = n0 + ln * 2 + (aidx & 1);
                MOD[((size_t)l * 9 + j) * NMOD + n] = s + IN(I_BMOD)[(size_t)l * NMOD + n];
            }
            __syncthreads();
        }
    }
    grid.sync();
    if (threadIdx.x == 0) { const unsigned jl = xb_add(&xbar.bar[XB_XCNT(xbar.x)], 1u); bst[2] = jl; }

    for (int l = 0; l < DEPTH; ++l) {
        const bool last = (l == DEPTH - 1);
        const int Mrows = last ? TL : TT;

        {
            PHASE_IDS();
            LAS float* scr = (LAS float*)(lds + wave * 16384);
            constexpr int IT_IN = 16 * 77, IT_OUT = 16 * 32, IT_W1 = 16 * 128, IT_W2 = 64 * 32, IT_UQ = 4 * 12, IT_UKV = 2 * 16, IT_PW = 4 * 8;
            constexpr int NIT = IT_IN + IT_OUT + IT_W1 + IT_W2 + IT_UQ + IT_UKV + IT_PW;
            for (int it = gw; it < NIT; it += NGW) {
                int r = it;
                if (r < IT_IN) { transpose_item(IN(I_WIN) + (size_t)l * DM * DIN, DM, DIN, WINT, scr, r, lane); continue; } r -= IT_IN;
                if (r < IT_OUT) { transpose_item(IN(I_WOUT) + (size_t)l * DM * DM, DM, DM, WOUTT, scr, r, lane); continue; } r -= IT_OUT;
                if (r < IT_W1) { transpose_item(IN(I_W1) + (size_t)l * DM * DFF, DM, DFF, W1T, scr, r, lane); continue; } r -= IT_W1;
                if (r < IT_W2) { transpose_item(IN(I_W2) + (size_t)l * DFF * DM, DFF, DM, W2T, scr, r, lane); continue; } r -= IT_W2;
                if (r < IT_UQ) { transpose_item(IN(I_MUQ) + (size_t)l * 256 * 384, 256, 384, UQT, scr, r, lane); continue; } r -= IT_UQ;
                if (r < IT_UKV) { transpose_item(IN(I_MUKV) + (size_t)l * 128 * 512, 128, 512, UKVT, scr, r, lane); continue; } r -= IT_UKV;
                transpose_item(IN(I_CPW) + (size_t)l * 256 * 256, 256, 256, PWT, scr, r, lane);
            }
            if (bid == 0 && tid < 168) ((unsigned*)(ws + WS_NB))[tid] = 0u;
            {
                const int gt = bid * 512 + tid, ngt = G * 512; unsigned zz = 0u; asm volatile("" : "+v"(zz)); const u32x4 z = {zz, zz, zz, zz};
                u32x4* p0 = (u32x4*)(WINT + (size_t)DIN * DM);
                for (int i = gt; i < (DINP - DIN) * DM / 8; i += ngt) p0[i] = z;
                u32x4* p1 = (u32x4*)(UQT + (size_t)384 * 256);
                for (int i = gt; i < 128 * 256 / 8; i += ngt) p1[i] = z;
            }
            for (int m = gw; m < TT; m += NGW) {
                const bool isl = m < TL; const int j = isl ? (m >> 12) : 8;
                if (!isl && l > 0) {
                    f32x4* cr = (f32x4*)(CX + (size_t)(m - TL) * DM) + lane;
                    const f32x4* pr = (const f32x4*)((const float*)(ws + WS_KVM) + (size_t)(m - TL) * DM) + lane;
                    const f32x4* gp = (const f32x4*)(MOD + (size_t)(l - 1) * 9 * NMOD + (size_t)8 * NMOD + 5 * DM) + lane;
#pragma unroll
                    for (int jj = 0; jj < 4; ++jj) {
                        const f32x4 p = (pr[64 * jj] + pr[64 * jj + (size_t)TC * DM / 4]) + (pr[64 * jj + 2 * (size_t)TC * DM / 4] + pr[64 * jj + 3 * (size_t)TC * DM / 4]);
                        cr[64 * jj] = cr[64 * jj] + gp[64 * jj] * p;
                    }
                    asm volatile("s_waitcnt vmcnt(0)" ::: "memory");
                }
                const float* xr = isl ? xlat_in + (size_t)m * DM : xctx_in + (size_t)(m - TL) * DM;
                norm_row_mod(xr, modl + (size_t)j * NMOD + 0 * DM, modl + (size_t)j * NMOD + 1 * DM, XN + (size_t)m * DM, lane);
            }
        }
        GRID_BAR();

        if (l == 0) {
            if (threadIdx.x == 0) {
                bool ok = (G == 256);
#pragma unroll
                for (unsigned jx = 0; jx < 16; ++jx) { const unsigned cnt = xb_ld(&xbar.bar[XB_XCNT(jx)]); ok = ok && (cnt == (jx < 8 ? 32u : 0u)); }
                bst[3] = ok ? (bst[2] * 8u + xbar.x) : (unsigned)blockIdx.x;
            }
            __syncthreads();
            bid = __builtin_amdgcn_readfirstlane((int)bst[3]);
        }

        {
            PHASE_IDS();
            pg8::Gemm g{XN, WINT, TT, DINP, DM, DM}; pg8::StaticOrder S; S.init(TT, DINP, G, bid, g.K);
            pg8::EpiBf16<0> E{U, DINP};
            for (int rep = 0; rep < PROBE_GEMM; ++rep)
            pg8::gemm_phase<pg8::EpiBf16<0>, pg8::StaticOrder>(lds, g, S, E, tid);
        }
        GRID_BAR();

        {
            PHASE_IDS();
            LAS float* glu = (LAS float*)lds;
            LAS float* dwl = glu + 94 * 256;
            const float* dw = IN(I_CDW) + (size_t)l * 31 * 256;
            for (int i = tid; i < 31 * 256; i += 512) dwl[i] = dw[i];
            const f32x4 cb4 = *(const f32x4*)(IN(I_CB) + l * 256 + 4 * lane), lg4 = *(const f32x4*)(IN(I_CLG) + l * 256 + 4 * lane), lb4 = *(const f32x4*)(IN(I_CLB) + l * 256 + 4 * lane);
            const f32x4 gq4 = *(const f32x4*)(IN(I_MQG) + l * 256 + 4 * lane);
            const f32x2 gkv2 = *(const f32x2*)(IN(I_MKVG) + l * 128 + 2 * lane);
            const int i16 = lane & 15;
            float gg_q[4], gg_k[4];
#pragma unroll
            for (int e = 0; e < 4; ++e) { gg_q[e] = IN(I_GQG)[l * 64 + 16 * e + i16]; gg_k[e] = IN(I_GKG)[l * 64 + 16 * e + i16]; }
            const float fr16 = fexp2(-(float)i16 * (LOG2_ROPE / 16.f)) * INV_2PI;
            const float fr8 = fexp2(-(float)(lane & 7) * (LOG2_ROPE / 8.f)) * INV_2PI;
            for (int tile = bid; tile < TT / 64; tile += G) {
                const int r0 = tile * 64;
                const int seq_lo = (r0 < TL) ? (r0 & ~4095) : (TL + ((r0 - TL) & ~255));
                const int seq_hi = (r0 < TL) ? seq_lo + 4096 : seq_lo + 256;
                u32x2 pva[12], pvg[12];
#pragma unroll
                for (int q = 0; q < 12; ++q) { const int it = tid + 512 * q; const int rr = it >> 6, c4 = (it & 63) * 4; const int row = r0 - 15 + rr;
                    pva[q] = (u32x2){0u, 0u}; pvg[q] = (u32x2){0u, 0u};
                    if (it < 94 * 64 && row >= seq_lo && row < seq_hi) { pva[q] = *(const u32x2*)(U + (size_t)row * DINP + C_A + c4); pvg[q] = *(const u32x2*)(U + (size_t)row * DINP + C_A + 256 + c4); } }
                __syncthreads();
#pragma unroll
                for (int q = 0; q < 12; ++q) { const int it = tid + 512 * q; const int rr = it >> 6, c4 = (it & 63) * 4;
                    if (it < 94 * 64) { const u32x2 va = pva[q], vg = pvg[q]; f32x4 gv;
                        gv.x = bflo(va.x) * sigmoidf_(bflo(vg.x)); gv.y = bfhi(va.x) * sigmoidf_(bfhi(vg.x)); gv.z = bflo(va.y) * sigmoidf_(bflo(vg.y)); gv.w = bfhi(va.y) * sigmoidf_(bfhi(vg.y));
                        *(LAS f32x4*)(glu + rr * 256 + c4) = gv; } }
                __syncthreads();
#pragma unroll 1
                for (int tg = 0; tg < 2; ++tg) {
                    const int tl0 = wave * 8 + tg * 4;
                    f32x4 acc4[4] = {cb4, cb4, cb4, cb4};
                    f32x4 dwin[4];
#pragma unroll
                    for (int k = 0; k < 4; ++k) dwin[k] = (f32x4){0.f, 0.f, 0.f, 0.f};
#pragma unroll
                    for (int r = 0; r < 34; ++r) {
                        const f32x4 gx = *(const LAS f32x4*)(glu + (tl0 + r) * 256 + 4 * lane);
#pragma unroll
                        for (int k = 3; k > 0; --k) dwin[k] = dwin[k - 1];
                        dwin[0] = (r < 31) ? *(const LAS f32x4*)(dwl + r * 256 + 4 * lane) : (f32x4){0.f, 0.f, 0.f, 0.f};
#pragma unroll
                        for (int k = 0; k < 4; ++k) if (r - k >= 0 && r - k < 31) acc4[k] += gx * dwin[k];
                    }
#pragma unroll
                    for (int k = 0; k < 4; ++k) {
                        const int row = r0 + tl0 + k; const f32x4 acc = acc4[k];
                        const float mean = wave_sum((acc.x + acc.y) + (acc.z + acc.w), lane) * (1.f / 256.f);
                        const f32x4 d = acc - mean;
                        const float var = wave_sum((d.x * d.x + d.y * d.y) + (d.z * d.z + d.w * d.w), lane) * (1.f / 256.f);
                        f32x4 y = d * rsqrtf(var + EPS) * lg4 + lb4;
                        y.x *= sigmoidf_(y.x); y.y *= sigmoidf_(y.y); y.z *= sigmoidf_(y.z); y.w *= sigmoidf_(y.w);
                        u32x2 w2; w2.x = cvt_pk_bf16(y.x, y.y); w2.y = cvt_pk_bf16(y.z, y.w);
                        *(u32x2*)(CA + (size_t)row * 256 + 4 * lane) = w2;
                    }
                }
                float kpe2 = 0.f;
#pragma unroll 4
                for (int tk = 0; tk < 8; ++tk) {
                    const int tl = wave * 8 + tk; const int row = r0 + tl;
                    bf16_t* ur = U + (size_t)row * DINP;
                    const bool isl = row < TL; const int tpos = row & 4095;
                    const float prow = (float)(tpos >> 6), pcol = (float)(tpos & 63);
                    {
                        const u32x2 v = *(const u32x2*)(ur + C_CQ + 4 * lane);
                        f32x4 x = {bflo(v.x), bfhi(v.x), bflo(v.y), bfhi(v.y)};
                        const float rs = rsqrtf(wave_sum((x.x * x.x + x.y * x.y) + (x.z * x.z + x.w * x.w), lane) * (1.f / 256.f) + EPS);
                        x = x * rs * gq4;
                        u32x2 w2; w2.x = cvt_pk_bf16(x.x, x.y); w2.y = cvt_pk_bf16(x.z, x.w);
                        *(u32x2*)(ur + C_CQ + 4 * lane) = w2;
                    }
                    {
                        const unsigned v = *(const unsigned*)(ur + C_CKV + 2 * lane);
                        float x0 = bflo(v), x1 = bfhi(v);
                        const float rs = rsqrtf(wave_sum(x0 * x0 + x1 * x1, lane) * (1.f / 128.f) + EPS);
                        *(unsigned*)(ur + C_CKV + 2 * lane) = cvt_pk_bf16(x0 * rs * gkv2.x, x1 * rs * gkv2.y);
                    }
                    {
                        const int blk = (lane >> 3) & 1, i = lane & 7;
                        bf16_t* p = ur + C_KPE + 16 * blk + i;
                        const float x1 = bf1(p[0]), x2 = bf1(p[8]);
                        kpe2 = fmaxf(kpe2, (lane < 16) ? (x1 * x1 + x2 * x2) : 0.f);
                        if (isl && lane < 16) {
                            const float rev = (blk ? pcol : prow) * fr8;
                            const float cs = __builtin_amdgcn_cosf(rev), sn = __builtin_amdgcn_sinf(rev);
                            p[0] = f2bf(x1 * cs - x2 * sn); p[8] = f2bf(x1 * sn + x2 * cs);
                        }
                    }
#pragma unroll
                    for (int pass = 0; pass < 2; ++pass) {
                        const int hd = lane >> 4;
                        const bool act = (pass == 0) || (lane < 32);
                        bf16_t* p = ur + (pass == 0 ? C_GQ : C_GK) + (act ? hd : 0) * 64 + i16;
                        float x0 = bf1(p[0]), x1 = bf1(p[16]), x2 = bf1(p[32]), x3 = bf1(p[48]);
                        const float rs = rsqrtf(sum16((x0 * x0 + x1 * x1) + (x2 * x2 + x3 * x3), lane) * (1.f / 64.f) + EPS);
                        if (pass == 0) { const float rq = rs * (0.125f * LOG2E); x0 *= rq * gg_q[0]; x1 *= rq * gg_q[1]; x2 *= rq * gg_q[2]; x3 *= rq * gg_q[3]; }
                        else { x0 *= rs * gg_k[0]; x1 *= rs * gg_k[1]; x2 *= rs * gg_k[2]; x3 *= rs * gg_k[3]; }
                        if (isl) {
                            const float rr = prow * fr16, rc = pcol * fr16;
                            const float c0 = __builtin_amdgcn_cosf(rr), s0 = __builtin_amdgcn_sinf(rr), c1 = __builtin_amdgcn_cosf(rc), s1 = __builtin_amdgcn_sinf(rc);
                            const float y0 = x0 * c0 - x1 * s0, y1 = x0 * s0 + x1 * c0, y2 = x2 * c1 - x3 * s1, y3 = x2 * s1 + x3 * c1;
                            x0 = y0; x1 = y1; x2 = y2; x3 = y3;
                        }
                        if (act) { p[0] = f2bf(x0); p[16] = f2bf(x1); p[32] = f2bf(x2); p[48] = f2bf(x3); }
                    }
                }
                { const float k2 = wave_sum(kpe2, lane) * 1.02f; const int bb = (r0 < TL) ? (r0 >> 12) : ((r0 - TL) >> 8);
                  if (lane == 0) atomicMax((unsigned*)(ws + WS_NB) + 160 + bb, __float_as_uint(k2)); }
            }
            __syncthreads();
            {
                LAS unsigned char* KF = lds;
                LAS unsigned char* KB = lds + 8192;
                LAS unsigned char* VS = lds + 16384;
                const int li = lane & 31, hi = lane >> 5;
                for (int u = (bid + 192) % G; u < NB * 4 * 34; u += G) {
                    const int b = u / 136, h = (u / 34) & 3, c = u % 34;
                    const int rowbase = (c < 2) ? TL + b * 256 + c * 128 : b * 4096 + (c - 2) * 128;
                    const float lgf2 = MOD[DEPTH * 9 * NMOD + l * 8 + h], lgb2 = MOD[DEPTH * 9 * NMOD + l * 8 + 4 + h];
                    const float kscale = 0.17677669529663687f;
                    u32x4 kv_pre, vv_pre[2];
                    { const int j = tid >> 2, part = tid & 3;
                      kv_pre = *(const u32x4*)(U + (size_t)(rowbase + j) * DINP + C_RK + h * 32 + part * 8);
#pragma unroll
                      for (int e = 0; e < 2; ++e) vv_pre[e] = *(const u32x4*)(U + (size_t)(rowbase + j) * DINP + C_RV + h * 64 + 8 * (part * 2 + e)); }
                    __syncthreads();
                    {
                        const int j = tid >> 2, part = tid & 3;
                        const u32x4 kv = kv_pre;
                        const float wf = fexp2(lgf2 * (float)(127 - j)) * kscale, wb = fexp2(lgb2 * (float)j) * kscale;
                        u32x4 f, g;
                        f.x = cvt_pk_bf16(bflo(kv.x) * wf, bfhi(kv.x) * wf); f.y = cvt_pk_bf16(bflo(kv.y) * wf, bfhi(kv.y) * wf); f.z = cvt_pk_bf16(bflo(kv.z) * wf, bfhi(kv.z) * wf); f.w = cvt_pk_bf16(bflo(kv.w) * wf, bfhi(kv.w) * wf);
                        g.x = cvt_pk_bf16(bflo(kv.x) * wb, bfhi(kv.x) * wb); g.y = cvt_pk_bf16(bflo(kv.y) * wb, bfhi(kv.y) * wb); g.z = cvt_pk_bf16(bflo(kv.z) * wb, bfhi(kv.z) * wb); g.w = cvt_pk_bf16(bflo(kv.w) * wb, bfhi(kv.w) * wb);
                        *(LAS u32x4*)(KF + j * 64 + part * 16) = f; *(LAS u32x4*)(KB + j * 64 + part * 16) = g;
#pragma unroll
                        for (int e = 0; e < 2; ++e) { const int cch = part * 2 + e;
                            const u32x4 vv = vv_pre[e];
                            *(LAS u32x4*)(VS + (j >> 2) * 512 + (cch >> 2) * 256 + (j & 3) * 64 + (cch & 3) * 16) = vv; }
                    }
                    __syncthreads();
                    if (wave < 4) {
                        const int dir = wave >> 1, dt = wave & 1;
                        const LAS unsigned char* Kd = dir ? KB : KF;
                        const int tro = ((lane & 15) >> 2) * 64 + ((lane >> 4) & 1) * 32 + (lane & 3) * 8;
                        f32x16 D;
#pragma unroll
                        for (int r = 0; r < 16; ++r) D[r] = 0.f;
#pragma unroll
                        for (int st = 0; st < 8; ++st) {
                            const int j0 = 16 * st + 8 * hi;
                            const v4i16_t a0 = vtr(Kd + j0 * 64 + tro), a1 = vtr(Kd + (j0 + 4) * 64 + tro);
                            const v4i16_t b0 = vtr(VS + (j0 >> 2) * 512 + dt * 256 + tro), b1 = vtr(VS + ((j0 >> 2) + 1) * 512 + dt * 256 + tro);
                            const bf16x8 af = __builtin_shufflevector(a0, a1, 0, 1, 2, 3, 4, 5, 6, 7), bfv = __builtin_shufflevector(b0, b1, 0, 1, 2, 3, 4, 5, 6, 7);
                            D = __builtin_amdgcn_mfma_f32_32x32x16_bf16(af, bfv, D, 0, 0, 0);
                        }
                        float* outp = CKV + ((size_t)u * 2 + dir) * 2048 + 32 * dt + li;
#pragma unroll
                        for (int r = 0; r < 16; ++r) outp[crow(r, hi) * 64] = D[r];
                    }
                }
            }
        }
        GRID_BAR();

        {
            PHASE_IDS();
            {
                const int gt = bid * 512 + tid;
                if (gt < 64 * 2048) {
                    const int chain = gt >> 11, e = gt & 2047, dir = chain & 1, bh = chain >> 1, h = bh & 3;
                    const float g128 = fexp2(MOD[DEPTH * 9 * NMOD + l * 8 + dir * 4 + h] * 128.f);
                    const int dk = e >> 6, d = e & 63;
                    float s = 0.f; float cv[34];
#pragma unroll
                    for (int p = 0; p < 34; ++p) {
                        const int c = (dir == 0) ? p : (p < 2 ? 1 - p : 35 - p);
                        cv[p] = CKV[(((size_t)(bh * 34 + c)) * 2 + dir) * 2048 + e];
                    }
#pragma unroll
                    for (int p = 0; p < 34; ++p) {
                        const int c = (dir == 0) ? p : (p < 2 ? 1 - p : 35 - p);
                        const size_t ud = ((size_t)(bh * 34 + c)) * 2 + dir;
                        SPT[ud * 2048 + d * 32 + dk] = f2bf(s);
                        s = s * g128 + cv[p];
                    }
                }
            }
            {
                pg8::Gemm g{CA, PWT, Mrows, 256, 256, 256}; pg8::StaticOrder S; S.init(Mrows, 256, G, bid, g.K);
                pg8::EpiBf16<0> E{YCAT, DM};
                pg8::gemm_phase<pg8::EpiBf16<0>, pg8::StaticOrder>(lds, g, S, E, tid);
            }
            {
                pg8::Gemm g{U + C_CQ, UQT, Mrows, 512, 256, DINP}; pg8::StaticOrder S; S.init(Mrows, 512, G, (bid + 120) % G, g.K);
                pg8::EpiBf16N<0> E{QM, 512, (unsigned*)(ws + WS_NB)};
                pg8::gemm_phase<pg8::EpiBf16N<0>, pg8::StaticOrder>(lds, g, S, E, tid);
            }
            {
                pg8::Gemm g{U + C_CKV, UKVT, TT, 512, 128, DINP}; pg8::StaticOrder S; S.init(TT, 512, G, (bid + 104) % G, g.K);
                pg8::EpiBf16N<1> E{KVM, 512, (unsigned*)(ws + WS_NB)};
                pg8::gemm_phase<pg8::EpiBf16N<1>, pg8::StaticOrder>(lds, g, S, E, tid);
            }
        }
        GRID_BAR();

        {
            PHASE_IDS();
            const float C_MLA = 0.10206207261596575f * LOG2E;
            const unsigned* nbp = (const unsigned*)(ws + WS_NB);
#define mla_safe(b_, h_) (__builtin_amdgcn_readfirstlane(__float_as_int(sqrtf((__uint_as_float(nbp[((b_) * 4 + (h_)) * 3]) + __uint_as_float(nbp[((b_) * 4 + (h_)) * 3 + 1]) + __uint_as_float(nbp[((b_) * 4 + (h_)) * 3 + 2])) * \
        (__uint_as_float(nbp[96 + ((b_) * 4 + (h_)) * 2]) + __uint_as_float(nbp[96 + ((b_) * 4 + (h_)) * 2 + 1]) + __uint_as_float(nbp[160 + (b_)]))) * C_MLA)) < __float_as_int(60.0f))
            bool gqa_safe;
            { float gq = fabsf(IN(I_GQG)[l * 64 + lane]), gk = fabsf(IN(I_GKG)[l * 64 + lane]);
#pragma unroll
              for (int o = 1; o < 64; o <<= 1) { gq = fmaxf(gq, shx(gq, o, lane)); gk = fmaxf(gk, shx(gk, o, lane)); }
              gqa_safe = __builtin_amdgcn_readfirstlane(__float_as_int(8.0f * gq * gk * LOG2E)) < __float_as_int(60.0f); }
            for (int rep = 0; rep < PROBE_ATT; ++rep) {
                const int xcd = bid & 7, j = bid >> 3;
                const int nm = 2 + ((!last && bid < 32) ? 1 : 0), ng = 2 + ((!last && bid >= 32 && bid < 64) ? 1 : 0);
#pragma unroll 1
                for (int r = 0; r < nm; ++r) {
                    const bool cx = (r == 2);
                    const int stream = xcd * 4 + (r & 1) * 2 + (j >> 4), b = cx ? (bid >> 2) : (stream >> 2), h = cx ? (bid & 3) : (stream & 3), qb = j & 15;
                    const int qrow0 = cx ? TL + b * 256 : b * 4096 + qb * 256, qpos0 = cx ? 0 : qb * 256, nkt = cx ? 4 : 68;
                    if (mla_safe(b, h)) attn_unit<96, true>(lds, QM + h * 96, 512, KVM + h * 128, 512, U + C_KPE, KVM + h * 128 + 64, 512, YCAT + 256 + h * 64, qrow0, qpos0, nkt, TL + b * 256, b * 4096, !cx, C_MLA, tid);
                    else attn_unit<96, false>(lds, QM + h * 96, 512, KVM + h * 128, 512, U + C_KPE, KVM + h * 128 + 64, 512, YCAT + 256 + h * 64, qrow0, qpos0, nkt, TL + b * 256, b * 4096, !cx, C_MLA, tid);
                }
#pragma unroll 1
                for (int r = 0; r < ng; ++r) {
                    const bool cx = (r == 2);
                    const int stream = xcd * 2 + (r & 1), bh = bid & 31;
                    const int b = cx ? (bh >> 2) : (stream >> 1), kvh = cx ? ((bh & 3) >> 1) : (stream & 1), h = cx ? (bh & 3) : kvh * 2 + (j >> 4), qb = j & 15;
                    const int qrow0 = cx ? TL + b * 256 : b * 4096 + qb * 256, qpos0 = cx ? 0 : qb * 256, nkt = cx ? 4 : 68;
                    if (gqa_safe) attn_unit<64, true>(lds, U + C_GQ + h * 64, DINP, U + C_GK + kvh * 64, DINP, nullptr, U + C_GV + kvh * 64, DINP, YCAT + 512 + h * 64, qrow0, qpos0, nkt, TL + b * 256, b * 4096, !cx, 1.0f, tid);
                    else attn_unit<64, false>(lds, U + C_GQ + h * 64, DINP, U + C_GK + kvh * 64, DINP, nullptr, U + C_GV + kvh * 64, DINP, YCAT + 512 + h * 64, qrow0, qpos0, nkt, TL + b * 256, b * 4096, !cx, 1.0f, tid);
                }
            }
            {
                PHASE_IDS();
                constexpr int VS2 = 264;
                LAS unsigned char* VT = lds;
                LAS float* YX = (LAS float*)(lds + 17408);
                const int c0 = last ? 2 : 0, nC = 34 - c0, nU = NB * 4 * nC;
                const int li = lane & 31, hi = lane >> 5, qg = wave & 3, dir = wave >> 2;
                for (int uu = (bid + 192) % G; uu < nU; uu += G) {
                    const int b = uu / (4 * nC), h = (uu / nC) & 3, c = c0 + uu % nC;
                    const int rowbase = (c < 2) ? TL + b * 256 + c * 128 : b * 4096 + (c - 2) * 128;
                    const float lg2 = MOD[DEPTH * 9 * NMOD + l * 8 + dir * 4 + h];
                    const float kscale = 0.17677669529663687f;
                    u32x4 vst[2];
#pragma unroll
                    for (int e = 0; e < 2; ++e) { const int idx = tid + 512 * e, key = idx >> 3, dch = idx & 7;
                        vst[e] = *(const u32x4*)(U + (size_t)(rowbase + key) * DINP + C_RV + h * 64 + 8 * dch); }
                    const int qi = 32 * qg + li; const size_t rowi = (size_t)(rowbase + qi);
                    bf16x8 qf[2];
#pragma unroll
                    for (int s = 0; s < 2; ++s) qf[s] = *(const bf16x8*)(U + rowi * DINP + C_RQ + h * 32 + 16 * s + 8 * hi);
                    bf16x8 kfa[4][2], spf[2][2]; u32x2 gtv[8];
#pragma unroll
                    for (int jt = 0; jt < 4; ++jt)
#pragma unroll
                        for (int s = 0; s < 2; ++s) kfa[jt][s] = *(const bf16x8*)(U + (size_t)(rowbase + 32 * jt + li) * DINP + C_RK + h * 32 + 16 * s + 8 * hi);
                    { const bf16_t* sp = SPT + ((((size_t)(b * 4 + h) * 34 + c) * 2 + dir) * 2048);
#pragma unroll
                      for (int s = 0; s < 2; ++s) { spf[0][s] = *(const bf16x8*)(sp + li * 32 + 16 * s + 8 * hi); spf[1][s] = *(const bf16x8*)(sp + (32 + li) * 32 + 16 * s + 8 * hi); } }
                    { const bf16_t* gp0 = U + rowi * DINP + (dir == 0 ? C_GF : C_GB) + h * 64;
#pragma unroll
                      for (int dt = 0; dt < 2; ++dt)
#pragma unroll
                          for (int rg = 0; rg < 4; ++rg) gtv[dt * 4 + rg] = *(const u32x2*)(gp0 + 32 * dt + 8 * rg + 4 * hi); }
                    __syncthreads();
#pragma unroll
                    for (int e = 0; e < 2; ++e) { const int idx = tid + 512 * e, key = idx >> 3, dch = idx & 7;
                        *(LAS u32x4*)(VT + (key >> 2) * 512 + (dch >> 2) * 256 + (key & 3) * 64 + (dch & 3) * 16) = vst[e]; }
                    __syncthreads();
                    f32x16 O0, O1;
#pragma unroll
                    for (int r = 0; r < 16; ++r) { O0[r] = 0.f; O1[r] = 0.f; }
#pragma unroll
                    for (int jt = 0; jt < 4; ++jt) {
                        if (dir == 0 ? (jt > qg) : (jt < qg)) continue;
                        f32x16 S;
#pragma unroll
                        for (int r = 0; r < 16; ++r) S[r] = 0.f;
#pragma unroll
                        for (int s = 0; s < 2; ++s) {
                            S = __builtin_amdgcn_mfma_f32_32x32x16_bf16(kfa[jt][s], qf[s], S, 0, 0, 0);
                        }
#pragma unroll
                        for (int r = 0; r < 16; ++r) {
                            const int j = 32 * jt + crow(r, hi);
                            const int diff = (dir == 0) ? (qi - j) : (j - qi);
                            const float w = (diff >= 0) ? fexp2(lg2 * (float)diff) * kscale : 0.f;
                            S[r] *= w;
                        }
#pragma unroll
                        for (int e = 0; e < 2; ++e) {
                            u32x4 w0;
                            w0.x = cvt_pk_bf16(S[8 * e + 0], S[8 * e + 1]); w0.y = cvt_pk_bf16(S[8 * e + 2], S[8 * e + 3]); w0.z = cvt_pk_bf16(S[8 * e + 4], S[8 * e + 5]); w0.w = cvt_pk_bf16(S[8 * e + 6], S[8 * e + 7]);
                            const bf16x8 pb = __builtin_bit_cast(bf16x8, w0);
                            const int ks = 2 * jt + e;
                            const LAS unsigned char* vb = VT + hi * 512 + ((lane & 15) >> 2) * 64 + ((lane >> 4) & 1) * 32 + (lane & 3) * 8 + ks * 2048;
                            const v4i16_t l0 = vtr(vb), h0 = vtr(vb + 1024), l1 = vtr(vb + 256), h1 = vtr(vb + 1024 + 256);
                            const bf16x8 a0 = __builtin_shufflevector(l0, h0, 0, 1, 2, 3, 4, 5, 6, 7), a1 = __builtin_shufflevector(l1, h1, 0, 1, 2, 3, 4, 5, 6, 7);
                            O0 = __builtin_amdgcn_mfma_f32_32x32x16_bf16(a0, pb, O0, 0, 0, 0);
                            O1 = __builtin_amdgcn_mfma_f32_32x32x16_bf16(a1, pb, O1, 0, 0, 0);
                        }
                    }
                    {
                        f32x16 X0, X1;
#pragma unroll
                        for (int r = 0; r < 16; ++r) { X0[r] = 0.f; X1[r] = 0.f; }
#pragma unroll
                        for (int s = 0; s < 2; ++s) {
                            X0 = __builtin_amdgcn_mfma_f32_32x32x16_bf16(spf[0][s], qf[s], X0, 0, 0, 0);
                            X1 = __builtin_amdgcn_mfma_f32_32x32x16_bf16(spf[1][s], qf[s], X1, 0, 0, 0);
                        }
                        const float dec = fexp2(lg2 * (float)(dir == 0 ? qi + 1 : 128 - qi));
#pragma unroll
                        for (int r = 0; r < 16; ++r) { O0[r] += dec * X0[r]; O1[r] += dec * X1[r]; }
                    }
                    float ss = 0.f;
#pragma unroll
                    for (int r = 0; r < 16; ++r) ss += O0[r] * O0[r] + O1[r] * O1[r];
                    ss += shx(ss, 32, lane);
                    const float rs = rsqrtf(ss * (1.f / 64.f) + EPS);
                    const float* ng = IN(I_RNG) + ((size_t)(l * 2 + dir) * 4 + h) * 64;
                    f32x4 yv[8];
#pragma unroll
                    for (int dt = 0; dt < 2; ++dt)
#pragma unroll
                        for (int rg = 0; rg < 4; ++rg) {
                            const int d0 = 32 * dt + 8 * rg + 4 * hi;
                            const u32x2 gt2 = gtv[dt * 4 + rg]; const f32x4 gn = *(const f32x4*)(ng + d0);
                            const float g0 = bflo(gt2.x), g1 = bfhi(gt2.x), g2 = bflo(gt2.y), g3 = bfhi(gt2.y);
                            f32x4 y;
                            if (dt == 0) { y.x = O0[4 * rg]; y.y = O0[4 * rg + 1]; y.z = O0[4 * rg + 2]; y.w = O0[4 * rg + 3]; }
                            else { y.x = O1[4 * rg]; y.y = O1[4 * rg + 1]; y.z = O1[4 * rg + 2]; y.w = O1[4 * rg + 3]; }
                            y = y * rs * gn;
                            y.x *= g0 * sigmoidf_(g0); y.y *= g1 * sigmoidf_(g1); y.z *= g2 * sigmoidf_(g2); y.w *= g3 * sigmoidf_(g3);
                            yv[dt * 4 + rg] = y;
                        }
                    if (dir == 1) {
#pragma unroll
                        for (int dt = 0; dt < 2; ++dt)
#pragma unroll
                            for (int rg = 0; rg < 4; ++rg) *(LAS f32x4*)(YX + qi * 64 + 32 * dt + 8 * rg + 4 * hi) = yv[dt * 4 + rg];
                    }
                    __syncthreads();
                    if (dir == 0) {
                        bf16_t* yo = YCAT + rowi * DM + 768 + h * 64;
#pragma unroll
                        for (int dt = 0; dt < 2; ++dt)
#pragma unroll
                            for (int rg = 0; rg < 4; ++rg) {
                                const int d0 = 32 * dt + 8 * rg + 4 * hi;
                                const f32x4 y = yv[dt * 4 + rg] + *(const LAS f32x4*)(YX + qi * 64 + d0);
                                u32x2 w2; w2.x = cvt_pk_bf16(y.x, y.y); w2.y = cvt_pk_bf16(y.z, y.w);
                                *(u32x2*)(yo + d0) = w2;
                            }
                    }
                }
                __syncthreads();
            }
        }
        GRID_BAR();

        {
            PHASE_IDS();
            pg8::Gemm g{YCAT, WOUTT, Mrows, DM, DM, DM}; pg8::StaticOrder S; S.init(Mrows, DM, G, bid, g.K);
            pg8::EpiRes E{xlat_in, xctx_in, OUTP, CX, modl + 2 * DM, nullptr};
            pg8::gemm_phase<pg8::EpiRes, pg8::StaticOrder>(lds, g, S, E, tid);
        }
        GRID_BAR();

        { PHASE_IDS();
        for (int rep = 0; rep < PROBE_AUX; ++rep)
        for (int m = gw; m < Mrows; m += NGW) {
            const bool isl = m < TL; const int j = isl ? (m >> 12) : 8;
            const float* xr = isl ? OUTP + (size_t)m * DM : CX + (size_t)(m - TL) * DM;
            norm_row_mod(xr, modl + (size_t)j * NMOD + 3 * DM, modl + (size_t)j * NMOD + 4 * DM, XN + (size_t)m * DM, lane);
        }
        }
        GRID_BAR();

        {
            PHASE_IDS();
            pg8::Gemm g{XN, W1T, Mrows, DFF, DM, DM}; pg8::StaticOrder S; S.init(Mrows, DFF, G, bid, g.K);
            pg8::EpiBf16<1> E{HB, DFF};
            for (int rep = 0; rep < PROBE_GEMM; ++rep)
            pg8::gemm_phase<pg8::EpiBf16<1>, pg8::StaticOrder>(lds, g, S, E, tid);
        }
        GRID_BAR();

        {
            PHASE_IDS();
            pg8::Gemm g{HB, W2T, Mrows, DM, DFF, DFF}; pg8::StaticOrder S; S.init(TL, DM, G, bid, g.K);
            if (!last) S.extra(TL / 256, TC / 256, 4);
            pg8::EpiRes E{OUTP, CX, OUTP, CX, modl + 5 * DM, last ? (float*)nullptr : (float*)(ws + WS_KVM)};
            pg8::gemm_phase<pg8::EpiRes, pg8::StaticOrder>(lds, g, S, E, tid);
        }
        GRID_BAR();
    }

    { PHASE_IDS();
    for (int m = gw; m < TL; m += NGW) {
        f32x4* xr = (f32x4*)(OUTP + (size_t)m * DM) + lane;
        f32x4 v[4]; float s = 0.f;
#pragma unroll
        for (int j = 0; j < 4; ++j) { v[j] = xr[64 * j]; s += (v[j].x * v[j].x + v[j].y * v[j].y) + (v[j].z * v[j].z + v[j].w * v[j].w); }
        const float rstd = rsqrtf(wave_sum(s, lane) * (1.f / DM) + EPS);
#pragma unroll
        for (int j = 0; j < 4; ++j) xr[64 * j] = v[j] * rstd * ((const f32x4*)IN(I_FG))[lane + 64 * j];
    }
    }
}

extern "C" void kernel_launch(void* const* d_in, const int* in_sizes, int n_in, void* d_out, int out_size, void* d_ws, size_t ws_size, hipStream_t stream) {
    static int grid = 0;
    if (grid == 0) {
        int dev = 0, cus = 0, per_cu = 0;
        (void)hipGetDevice(&dev);
        (void)hipDeviceGetAttribute(&cus, hipDeviceAttributeMultiprocessorCount, dev);
        (void)hipFuncSetAttribute((const void*)mega_fwd, hipFuncAttributeMaxDynamicSharedMemorySize, LDS_BYTES);
        (void)hipOccupancyMaxActiveBlocksPerMultiprocessor(&per_cu, (const void*)mega_fwd, 512, LDS_BYTES);
        if (per_cu < 1) per_cu = 1;
        grid = cus * per_cu;
        if (grid != 256) fprintf(stderr, "kernel_launch: grid %d (expected 256)\n", grid);
        if (ws_size < WS_END || n_in != 24) { fprintf(stderr, "kernel_launch: ws %zu < %zu or n_in %d\n", ws_size, (size_t)WS_END, n_in); grid = -1; }
    }
    if (grid < 0) return;
    Args a{};
    for (int i = 0; i < 24; ++i) a.in[i] = (const float*)d_in[i];
    a.out = (float*)d_out; a.ws = (unsigned char*)d_ws;
    void* args[] = {&a};
    hipError_t e = hipLaunchCooperativeKernel((const void*)mega_fwd, dim3(grid), dim3(512), args, LDS_BYTES, stream);
    if (e != hipSuccess) fprintf(stderr, "cooperative launch failed: %s (grid %d)\n", hipGetErrorString(e), grid);
}
```

```cpp
#include <hip/hip_runtime.h>
#include <hip/hip_cooperative_groups.h>
#include <cstdio>
#include <cstdint>
namespace cg = cooperative_groups;
#ifndef PROBE_ATT
#define PROBE_ATT 1
#endif
#ifndef PROBE_GEMM
#define PROBE_GEMM 1
#endif
#ifndef PROBE_AUX
#define PROBE_AUX 1
#endif

#define LAS __attribute__((address_space(3)))
typedef unsigned short bf16_t;
typedef short bf16x8 __attribute__((ext_vector_type(8)));
typedef float f32x4 __attribute__((ext_vector_type(4)));
typedef float f32x2 __attribute__((ext_vector_type(2)));
typedef float f32x16 __attribute__((ext_vector_type(16)));
typedef unsigned u32x4 __attribute__((ext_vector_type(4)));
typedef unsigned u32x2 __attribute__((ext_vector_type(2)));

constexpr int NB = 8, SEQ = 4096, DM = 1024, DEPTH = 4, CTX = 256, DIN = 2464, DINP = 2560, DFF = 4096;
constexpr int TL = NB * SEQ, TC = NB * CTX, TT = TL + TC;
constexpr int NMOD = 6 * DM;
constexpr int C_A = 0, C_CQ = 512, C_CKV = 768, C_KPE = 896, C_GQ = 928, C_GK = 1184, C_GV = 1312, C_RQ = 1440, C_RK = 1568, C_RV = 1696, C_GF = 1952, C_GB = 2208;
constexpr float EPS = 1e-6f;
constexpr float LOG2_ROPE = 13.287712379549449f;
constexpr float INV_2PI = 0.15915494309189535f;
constexpr float LOG2E = 1.4426950408889634f;

constexpr size_t MiB = 1u << 20;
constexpr size_t WS_MOD = 0;
constexpr size_t WS_WIN = 1 * MiB;
constexpr size_t WS_WOUT = 6 * MiB;
constexpr size_t WS_W1 = 8 * MiB;
constexpr size_t WS_W2 = 16 * MiB;
constexpr size_t WS_UQ = 24 * MiB;
constexpr size_t WS_UKV = 24 * MiB + 256 * 1024;
constexpr size_t WS_PW = 24 * MiB + 512 * 1024;
constexpr size_t WS_CX = 25 * MiB;
constexpr size_t WS_CKV = 33 * MiB;
constexpr size_t WS_SPT = 51 * MiB;
constexpr size_t WS_XN = 60 * MiB;
constexpr size_t WS_U = 128 * MiB;
constexpr size_t WS_YCAT = 298 * MiB;
constexpr size_t WS_QM = 366 * MiB;
constexpr size_t WS_KVM = 400 * MiB;
constexpr size_t WS_H = 128 * MiB;
constexpr size_t WS_CTL = 434 * MiB;
constexpr size_t CTL_BYTES = 16384;
constexpr size_t WS_NB = WS_CTL + 32 * 1024;
constexpr size_t WS_END = 435 * MiB;

constexpr int LDS_BYTES = 131072 + 2048;

__device__ __forceinline__ unsigned cvt_pk_bf16(float lo, float hi) { unsigned r; asm volatile("v_cvt_pk_bf16_f32 %0, %1, %2" : "=v"(r) : "v"(lo), "v"(hi)); return r; }
__device__ __forceinline__ float bflo(unsigned w) { return __uint_as_float(w << 16); }
__device__ __forceinline__ float bfhi(unsigned w) { return __uint_as_float(w & 0xffff0000u); }
__device__ __forceinline__ float bf1(bf16_t h) { return __uint_as_float(((unsigned)h) << 16); }
__device__ __forceinline__ bf16_t f2bf(float f) { return (bf16_t)(cvt_pk_bf16(f, 0.f) & 0xffffu); }
__device__ __forceinline__ float shx(float v, int o, int lane) { return __int_as_float(__builtin_amdgcn_ds_bpermute((lane ^ o) << 2, __float_as_int(v))); }
__device__ __forceinline__ float wave_sum(float v, int lane) {
#pragma unroll
    for (int o = 1; o < 64; o <<= 1) v += shx(v, o, lane);
    return v;
}
__device__ __forceinline__ float sum16(float v, int lane) {
#pragma unroll
    for (int o = 1; o < 16; o <<= 1) v += shx(v, o, lane);
    return v;
}
__device__ __forceinline__ int crow(int r, int hi) { return (r & 3) + 8 * (r >> 2) + 4 * hi; }
__device__ __forceinline__ float sigmoidf_(float x) { return 1.0f / (1.0f + __expf(-x)); }
__device__ __forceinline__ float fexp2(float x) { return __builtin_amdgcn_exp2f(x); }

namespace pg8 {
constexpr int BM = 256, BK = 64, HALF = 128, HTB = HALF * BK * 2, STAGE_BYTES = 8 * HTB, NXCD = 8, WGM = 8;
__host__ __device__ __forceinline__ int lds_byte(int r, int c) { const int st = (r >> 4) * 2 + (c >> 5), rr = r & 15, cc = c & 31, ob = rr * 64 + cc * 2; return st * 1024 + (ob ^ (((ob >> 9) & 1) << 5)); }
__host__ __device__ __forceinline__ void stage_rc(int b, int& R, int& C) { const int st = b / 1024, sb = b % 1024, swz = sb ^ (((sb >> 9) & 1) << 5); R = (st >> 1) * 16 + swz / 64; C = (st & 1) * 32 + (swz % 64) / 2; }
__host__ __device__ __forceinline__ int perm32(int rho) { const int n = rho >> 4, i = rho & 15; return 8 * (i >> 2) + 4 * n + (i & 3); }

struct Unit { int pm, pn, koff, nt; };
struct Gemm { const bf16_t* A; const bf16_t* Bt; int M, N, K, lda; };

struct StaticOrder {
    int nM, nN, nwg, G, c, ntf, xt0, xnt, xsplit;
    __device__ __forceinline__ void init(int M, int N, int G_, int c_, int K) { nM = M / BM; nN = N / BM; nwg = nM * nN; G = G_; c = c_; ntf = K / BK; xt0 = 0; xnt = 0; xsplit = 1; }
    __device__ __forceinline__ void extra(int first_tile, int ntiles_m, int split) { xt0 = first_tile; xnt = ntiles_m * nN; xsplit = split; }
    __device__ __forceinline__ bool next(int i, Unit& u) const {
        const long L = (long)i * G + c;
        int pm, pn, koff = 0, nt = ntf;
        if (L >= nwg) {
            const int q = (int)(L - nwg); if (q >= xnt * xsplit) return false;
            const int tile = q / xsplit, ks = q % xsplit; pm = xt0 + tile / nN; pn = tile % nN; nt = ntf / xsplit; koff = ks * nt * BK;
        } else {
            int wgid = (int)L; { const int q = nwg / NXCD, r = nwg % NXCD, xcd = wgid % NXCD, off = wgid / NXCD; wgid = (xcd < r ? xcd * (q + 1) : r * (q + 1) + (xcd - r) * q) + off; }
            const int nig = WGM * nN, gid = wgid / nig, fm = gid * WGM, gsz = (nM - fm) < WGM ? (nM - fm) : WGM;
            pm = fm + ((wgid % nig) % gsz); pn = (wgid % nig) / gsz;
        }
        u.pm = pm; u.pn = pn; u.koff = koff; u.nt = nt; return true;
    }
};

template <int ACT  > struct EpiBf16 {
    static constexpr bool PERM = true;
    bf16_t* O; int ldc;
    __device__ __forceinline__ void operator()(const f32x4 (&acc)[2][2][4][2], const Unit& u, int wr, int wc, int fr, int fq) const {
        asm volatile("" : "+v"(fr), "+v"(fq));
        const int row0 = u.pm * BM + wr * 64 + fr; const int col0 = u.pn * BM + wc * 32 + 8 * fq;
#pragma unroll
        for (int ai = 0; ai < 2; ++ai)
#pragma unroll
            for (int m = 0; m < 4; ++m) { bf16_t* rowp = O + (size_t)(row0 + ai * HALF + m * 16) * ldc + col0;
#pragma unroll
                for (int bj = 0; bj < 2; ++bj) { f32x4 v0 = acc[ai][bj][m][0], v1 = acc[ai][bj][m][1];
                    if (ACT == 1) {
#pragma unroll
                        for (int e = 0; e < 4; ++e) { float a = fmaxf(v0[e], 0.f), b = fmaxf(v1[e], 0.f); v0[e] = a * a; v1[e] = b * b; } }
                    u32x4 w; w.x = cvt_pk_bf16(v0[0], v0[1]); w.y = cvt_pk_bf16(v0[2], v0[3]); w.z = cvt_pk_bf16(v1[0], v1[1]); w.w = cvt_pk_bf16(v1[2], v1[3]);
                    *(u32x4*)(rowp + bj * HALF) = w; } }
    }
};
template <int MODE  > struct EpiBf16N {
    static constexpr bool PERM = true;
    bf16_t* O; int ldc; unsigned* nb;
    __device__ __forceinline__ void operator()(const f32x4 (&acc)[2][2][4][2], const Unit& u, int wr, int wc, int fr, int fq) const {
        asm volatile("" : "+v"(fr), "+v"(fq));
        const int row0 = u.pm * BM + wr * 64 + fr; const int col0 = u.pn * BM + wc * 32 + 8 * fq;
        float mxs[2] = {0.f, 0.f};
#pragma unroll
        for (int ai = 0; ai < 2; ++ai)
#pragma unroll
            for (int m = 0; m < 4; ++m) { bf16_t* rowp = O + (size_t)(row0 + ai * HALF + m * 16) * ldc + col0;
#pragma unroll
                for (int bj = 0; bj < 2; ++bj) { const f32x4 v0 = acc[ai][bj][m][0], v1 = acc[ai][bj][m][1];
                    mxs[bj] = fmaxf(mxs[bj], ((v0[0] * v0[0] + v0[1] * v0[1]) + (v0[2] * v0[2] + v0[3] * v0[3])) + ((v1[0] * v1[0] + v1[1] * v1[1]) + (v1[2] * v1[2] + v1[3] * v1[3])));
                    u32x4 w; w.x = cvt_pk_bf16(v0[0], v0[1]); w.y = cvt_pk_bf16(v0[2], v0[3]); w.z = cvt_pk_bf16(v1[0], v1[1]); w.w = cvt_pk_bf16(v1[2], v1[3]);
                    *(u32x4*)(rowp + bj * HALF) = w; } }
        const int ln_ = fq * 16 + fr; const int b = (u.pm >= TL / BM) ? (u.pm - TL / BM) : (u.pm >> 4);
#pragma unroll
        for (int bj = 0; bj < 2; ++bj) {
            float v = mxs[bj];
            v += shx(v, 16, ln_); v += shx(v, 32, ln_);
#pragma unroll
            for (int o = 1; o < 16; o <<= 1) v = fmaxf(v, shx(v, o, ln_));
            const int cidx = 8 * u.pn + 4 * bj + wc;
            int slot = -1;
            if (MODE == 0) { if (cidx < 12) slot = (b * 4 + cidx / 3) * 3 + cidx % 3; }
            else { if ((cidx & 3) < 2) slot = 96 + (b * 4 + (cidx >> 2)) * 2 + (cidx & 3); }
            if (slot >= 0 && ln_ == 0) atomicMax(nb + slot, __float_as_uint(v * 1.02f));
        }
    }
};
struct EpiRes {
    static constexpr bool PERM = false;
    const float* base_lat; const float* base_ctx; float* out_lat; float* out_ctx; const float* gate;
    float* part;
    __device__ __forceinline__ void operator()(const f32x4 (&acc)[2][2][4][2], const Unit& u, int wr, int wc, int fr, int fq) const {
        asm volatile("" : "+v"(fr), "+v"(fq));
        const bool isctx = u.pm >= (TL / BM); const int j = isctx ? 8 : (u.pm >> 4);
        if (part && isctx) {
            const int ks = u.koff / (u.nt * BK);
            float* pp = part + ((size_t)ks * TC + (size_t)(u.pm - TL / BM) * BM) * DM + u.pn * BM + wc * 32 + 4 * fq;
#pragma unroll
            for (int ai = 0; ai < 2; ++ai)
#pragma unroll
                for (int m = 0; m < 4; ++m) { float* rp = pp + (size_t)(ai * HALF + wr * 64 + m * 16 + fr) * DM;
#pragma unroll
                    for (int bj = 0; bj < 2; ++bj)
#pragma unroll
                        for (int n = 0; n < 2; ++n) *(f32x4*)(rp + bj * HALF + n * 16) = acc[ai][bj][m][n]; }
            return;
        }
        const float* base = isctx ? base_ctx : base_lat; float* out = isctx ? out_ctx : out_lat;
        const int prow = isctx ? (u.pm - TL / BM) * BM : u.pm * BM;
        const float* g = gate + (size_t)j * NMOD;
        const int col0 = u.pn * BM + wc * 32 + 4 * fq;
        f32x4 gv[2][2];
#pragma unroll
        for (int bj = 0; bj < 2; ++bj)
#pragma unroll
            for (int n = 0; n < 2; ++n) gv[bj][n] = *(const f32x4*)(g + col0 + bj * HALF + n * 16);
#pragma unroll
        for (int ai = 0; ai < 2; ++ai) {
            f32x4 bs[4][2][2];
#pragma unroll
            for (int m = 0; m < 4; ++m) { const size_t off = (size_t)(prow + ai * HALF + wr * 64 + m * 16 + fr) * DM + col0;
#pragma unroll
                for (int bj = 0; bj < 2; ++bj)
#pragma unroll
                    for (int n = 0; n < 2; ++n) bs[m][bj][n] = *(const f32x4*)(base + off + bj * HALF + n * 16); }
            __builtin_amdgcn_sched_barrier(0);
#pragma unroll
            for (int m = 0; m < 4; ++m) { const size_t off = (size_t)(prow + ai * HALF + wr * 64 + m * 16 + fr) * DM + col0;
#pragma unroll
                for (int bj = 0; bj < 2; ++bj)
#pragma unroll
                    for (int n = 0; n < 2; ++n) *(f32x4*)(out + off + bj * HALF + n * 16) = bs[m][bj][n] + gv[bj][n] * acc[ai][bj][m][n]; }
            __builtin_amdgcn_sched_barrier(0);
        }
    }
};

template <class Epi, class Sched, bool ALIGN_EPI = true>
__device__ __forceinline__ void gemm_phase(LAS unsigned char* lds, const Gemm g, const Sched& S, const Epi& E, const int tid) {
    const int wid = __builtin_amdgcn_readfirstlane(tid >> 6), lane = tid & 63, wr = wid >> 2, wc = wid & 3, fr = lane & 15, fq = lane >> 4;
    const int K = g.K, lda = g.lda;
    unsigned voffA[2], voffB[2];
#define PG8_VOFFS(T_) do { _Pragma("unroll") for (int i = 0; i < 2; ++i) { int R, C; stage_rc((T_) * 16 + i * 8192, R, C); const int Rb = Epi::PERM ? ((R & ~31) + perm32(R & 31)) : R; \
        voffA[i] = (unsigned)(R * lda + C) * 2u; voffB[i] = (unsigned)(Rb * K + C) * 2u; } } while (0)
    PG8_VOFFS(tid);
    const size_t kstep = (size_t)(BK * 2);
    const size_t hstepA = (size_t)HALF * lda * 2, hstepB = (size_t)HALF * K * 2;
    const size_t tstepA = 2 * hstepA, tstepB = 2 * hstepB;
    const unsigned ldsw = (unsigned)wid * 1024u;
    int aoff = lds_byte(wr * 64 + fr, fq * 8), boff = lds_byte(wc * 32 + fr, fq * 8);
#define PG8_SA(b, h) (((b) * 2 + (h)) * HTB)
#define PG8_SB(b, h) ((4 + (b) * 2 + (h)) * HTB)
#define PG8_STAGE(bufoff, gbase, voff) do { _Pragma("unroll") for (int _i = 0; _i < 2; ++_i) \
        __builtin_amdgcn_global_load_lds((const unsigned*)((const char*)(gbase) + (voff)[_i]), (LAS unsigned*)(lds + (bufoff) + ldsw + _i * 8192), 16, 0, 0); } while (0)
#define PG8_LDA(dst, b, h) do { _Pragma("unroll") for (int m = 0; m < 4; ++m) _Pragma("unroll") for (int k = 0; k < 2; ++k) dst[m][k] = *(const LAS bf16x8*)(lds + PG8_SA(b, h) + aoff + m * 2048 + k * 1024); } while (0)
#define PG8_LDB(dst, b, h) do { _Pragma("unroll") for (int n = 0; n < 2; ++n) _Pragma("unroll") for (int k = 0; k < 2; ++k) dst[n][k] = *(const LAS bf16x8*)(lds + PG8_SB(b, h) + boff + n * 2048 + k * 1024); } while (0)
#define PG8_MMA(ai, bj, At, Bt) do { __builtin_amdgcn_s_setprio(1); _Pragma("unroll") for (int m = 0; m < 4; ++m) _Pragma("unroll") for (int n = 0; n < 2; ++n) _Pragma("unroll") for (int k = 0; k < 2; ++k) \
        acc[ai][bj][m][n] = __builtin_amdgcn_mfma_f32_16x16x32_bf16(Bt[n][k], At[m][k], acc[ai][bj][m][n], 0, 0, 0); __builtin_amdgcn_s_setprio(0); } while (0)
#define PG8_WAIT_V(n) asm volatile("s_waitcnt vmcnt(" #n ")" ::: "memory")
#define PG8_WAIT_L(n) asm volatile("s_waitcnt lgkmcnt(" #n ")" ::: "memory")
#define PG8_BAR __builtin_amdgcn_s_barrier()
#define PG8_SCHED __builtin_amdgcn_sched_barrier(0)
    Unit cur, nxt; int ui = 0;
    if (!S.next(0, cur)) return;
    f32x4 acc[2][2][4][2];
#pragma unroll
    for (int a = 0; a < 2; ++a)
#pragma unroll
        for (int b = 0; b < 2; ++b)
#pragma unroll
            for (int m = 0; m < 4; ++m)
#pragma unroll
                for (int n = 0; n < 2; ++n) acc[a][b][m][n] = (f32x4){0.f, 0.f, 0.f, 0.f};
    bf16x8 At[4][2], B0[2][2], B1[2][2];
    const char* cA = (const char*)g.A + (size_t)cur.pm * tstepA + (size_t)cur.koff * 2; const char* cB = (const char*)g.Bt + (size_t)cur.pn * tstepB + (size_t)cur.koff * 2;
    PG8_STAGE(PG8_SB(0, 0), cB, voffB); PG8_STAGE(PG8_SB(0, 1), cB + hstepB, voffB); PG8_STAGE(PG8_SA(0, 0), cA, voffA); PG8_STAGE(PG8_SA(0, 1), cA + hstepA, voffA);
    if (wr == 1) PG8_BAR;
    PG8_WAIT_V(2); PG8_BAR;
    PG8_STAGE(PG8_SB(1, 0), cB + kstep, voffB); PG8_STAGE(PG8_SA(1, 0), cA + kstep, voffA); PG8_STAGE(PG8_SB(1, 1), cB + hstepB + kstep, voffB);
    PG8_WAIT_V(6); PG8_BAR;
    for (;;) {
        const bool has_next = S.next(ui + 1, nxt);
        const char* nA = has_next ? (const char*)g.A + (size_t)nxt.pm * tstepA + (size_t)nxt.koff * 2 : cA; const char* nB = has_next ? (const char*)g.Bt + (size_t)nxt.pn * tstepB + (size_t)nxt.koff * 2 : cB;
        const int nt = cur.nt;
        for (int t = 0; t < nt; t += 2) {
            const bool last = (t == nt - 2);
            const char* a1 = cA + (size_t)(t + 1) * kstep;
            const char* a2 = last ? nA : cA + (size_t)(t + 2) * kstep; const char* b2 = last ? nB : cB + (size_t)(t + 2) * kstep;
            const char* a3 = a2 + kstep; const char* b3 = b2 + kstep;
            PG8_LDB(B0, 0, 0); PG8_LDB(B1, 0, 1); PG8_SCHED; PG8_LDA(At, 0, 0); PG8_STAGE(PG8_SA(1, 1), a1 + hstepA, voffA);
            PG8_WAIT_V(8); PG8_WAIT_L(0); PG8_BAR; PG8_MMA(0, 0, At, B0); PG8_MMA(0, 1, At, B1); PG8_BAR; PG8_SCHED;
            PG8_LDA(At, 0, 1); PG8_STAGE(PG8_SB(0, 0), b2, voffB); PG8_STAGE(PG8_SB(0, 1), b2 + hstepB, voffB); PG8_STAGE(PG8_SA(0, 0), a2, voffA);
            PG8_WAIT_V(8); PG8_WAIT_L(0); PG8_BAR; PG8_MMA(1, 0, At, B0); PG8_MMA(1, 1, At, B1); PG8_BAR; PG8_SCHED;
            PG8_LDB(B0, 1, 0); PG8_LDB(B1, 1, 1); PG8_SCHED; PG8_LDA(At, 1, 0); PG8_STAGE(PG8_SA(0, 1), a2 + hstepA, voffA);
            PG8_WAIT_V(8); PG8_WAIT_L(0); PG8_BAR; PG8_MMA(0, 0, At, B0); PG8_MMA(0, 1, At, B1); PG8_BAR; PG8_SCHED;
            PG8_LDA(At, 1, 1); PG8_STAGE(PG8_SB(1, 0), b3, voffB); PG8_STAGE(PG8_SB(1, 1), b3 + hstepB, voffB); PG8_STAGE(PG8_SA(1, 0), a3, voffA);
            PG8_WAIT_V(8); PG8_WAIT_L(0); PG8_BAR; PG8_MMA(1, 0, At, B0); PG8_MMA(1, 1, At, B1); PG8_BAR; PG8_SCHED;
        }
        if constexpr (ALIGN_EPI) { if (wr == 0) PG8_BAR; }
        E(acc, cur, wr, wc, fr, fq);
        if (!has_next) break;
#pragma unroll
        for (int a = 0; a < 2; ++a)
#pragma unroll
            for (int b = 0; b < 2; ++b)
#pragma unroll
                for (int m = 0; m < 4; ++m)
#pragma unroll
                    for (int n = 0; n < 2; ++n) acc[a][b][m][n] = (f32x4){0.f, 0.f, 0.f, 0.f};
        cur = nxt; cA = nA; cB = nB; ++ui;
        { int l2; asm volatile("v_mbcnt_lo_u32_b32 %0, -1, 0\n\tv_mbcnt_hi_u32_b32 %0, -1, %0" : "=v"(l2)); const int t2 = wid * 64 + l2; PG8_VOFFS(t2); const int fr2 = l2 & 15, fq2 = l2 >> 4; aoff = lds_byte(wr * 64 + fr2, fq2 * 8); boff = lds_byte(wc * 32 + fr2, fq2 * 8); }
        if constexpr (ALIGN_EPI) { if (wr == 1) PG8_BAR; }
    }
    PG8_WAIT_V(0);
    if constexpr (!ALIGN_EPI) { if (wr == 0) PG8_BAR; }
    PG8_BAR;
#undef PG8_SA
#undef PG8_SB
#undef PG8_STAGE
#undef PG8_LDA
#undef PG8_LDB
#undef PG8_MMA
#undef PG8_WAIT_V
#undef PG8_WAIT_L
#undef PG8_BAR
#undef PG8_SCHED
#undef PG8_VOFFS
}
}


#define XB_TMO      128
#define XB_XCNT(j)  (256  + 64 * (j))
#define XB_XSUB(j)  (1280 + 64 * (j))
#define XB_XGEN(j)  (2304 + 64 * (j))
#define XB_TOP      3328
#define XB_TOPGEN   3392
#define XCD_BAR_WORDS 3456
#define XB_SPIN_CAP (1u << 22)
__device__ __forceinline__ unsigned xb_ld(unsigned* p)              { return __hip_atomic_load(p, __ATOMIC_RELAXED, __HIP_MEMORY_SCOPE_AGENT); }
__device__ __forceinline__ unsigned xb_add(unsigned* p, unsigned v) { return __hip_atomic_fetch_add(p, v, __ATOMIC_RELAXED, __HIP_MEMORY_SCOPE_AGENT); }
__device__ __forceinline__ unsigned xb_xcc_id() { return (unsigned)__builtin_amdgcn_s_getreg((3 << 11) | 20) & 0xFu; }
#define XB_SPIN(cond, bar) do { unsigned _sp = 0; while (cond) { __builtin_amdgcn_s_sleep(1); \
    if ((++_sp & 255u) == 0u) { if (xb_ld(&(bar)[XB_TMO])) break; if (_sp > XB_SPIN_CAP) { atomicAdd(&(bar)[XB_TMO], 1u); break; } } } } while (0)
struct XcdBarrier { unsigned* bar; unsigned x; volatile LAS unsigned* st; };
__device__ __forceinline__ void xcd_barrier_complete(unsigned* bar, unsigned x, unsigned& nloc, unsigned& nx) {
    const unsigned G = gridDim.x * gridDim.y * gridDim.z;
    unsigned sum, cnt, mine, sp = 0u;
    for (;;) {
        sum = 0u; cnt = 0u; mine = 0u;
#pragma unroll
        for (unsigned j = 0; j < 16; ++j) { const unsigned c = xb_ld(&bar[XB_XCNT(j)]); sum += c; cnt += (c > 0u) ? 1u : 0u; mine = (j == x) ? c : mine; }
        if (sum == G) break;
        __builtin_amdgcn_s_sleep(1);
        if ((++sp & 255u) == 0u) { if (xb_ld(&bar[XB_TMO])) break; if (sp > XB_SPIN_CAP) { atomicAdd(&bar[XB_TMO], 1u); break; } }
    }
    nloc = mine > 0u ? mine : 1u; nx = cnt > 0u ? cnt : 1u;
}
__device__ __forceinline__ void xcd_barrier(const XcdBarrier& b, bool t0) {
    asm volatile("s_waitcnt vmcnt(0)" ::: "memory");
    __syncthreads();
    if (t0) {
        unsigned* bar = b.bar;
        __builtin_amdgcn_s_waitcnt(0);
        unsigned nloc = b.st[0], nx = b.st[1];
        if (nloc == 0u) { xcd_barrier_complete(bar, b.x, nloc, nx); b.st[0] = nloc; b.st[1] = nx; }
        const unsigned old = xb_add(&bar[XB_XSUB(b.x)], 1u);
        const unsigned gen = old / nloc;
        if (old + 1u == (gen + 1u) * nloc) {
            __builtin_amdgcn_fence(__ATOMIC_RELEASE, "agent");
            asm volatile("s_waitcnt vmcnt(0)" ::: "memory");
            const unsigned og = xb_add(&bar[XB_TOP], 1u);
            const unsigned tg = og / nx;
            if (og + 1u == (tg + 1u) * nx) xb_add(&bar[XB_TOPGEN], 1u);
            else XB_SPIN(xb_ld(&bar[XB_TOPGEN]) == tg, bar);
            __builtin_amdgcn_fence(__ATOMIC_ACQUIRE, "agent");
            xb_add(&bar[XB_XGEN(b.x)], 1u);
            asm volatile("s_waitcnt vmcnt(0)" ::: "memory");
        } else {
            XB_SPIN(xb_ld(&bar[XB_XGEN(b.x)]) == gen, bar);
            __builtin_amdgcn_fence(__ATOMIC_ACQUIRE, "agent");
            asm volatile("s_waitcnt vmcnt(0)" ::: "memory");
        }
    }
    __syncthreads();
}

struct Args { const float* in[24]; float* out; unsigned char* ws; };
enum { I_X = 0, I_C, I_CTX, I_CCTX, I_WMOD, I_BMOD, I_WIN, I_WOUT, I_CDW, I_CB, I_CLG, I_CLB, I_CPW, I_MQG, I_MKVG, I_MUQ, I_MUKV, I_GQG, I_GKG, I_RDEC, I_RNG, I_W1, I_W2, I_FG };

__device__ __forceinline__ void transpose_item(const float* W, int K, int N, bf16_t* WT, LAS float* scr, int item, int lane) {
    const int nblk = N / 32, kb = item / nblk, nb = item % nblk, k0 = 64 * kb, n0 = 32 * nb;
#pragma unroll 8
    for (int i = 0; i < 32; ++i) { const int kk = 2 * i + (lane >> 5); scr[kk * 33 + (lane & 31)] = W[(size_t)(k0 + kk) * N + n0 + (lane & 31)]; }
    asm volatile("s_waitcnt lgkmcnt(0)" ::: "memory");
    const int c = lane & 7;
#pragma unroll
    for (int j = 0; j < 4; ++j) { const int n = (lane >> 3) + 8 * j; const LAS float* s = scr + (8 * c) * 33 + n;
        u32x4 o; o.x = cvt_pk_bf16(s[0 * 33], s[1 * 33]); o.y = cvt_pk_bf16(s[2 * 33], s[3 * 33]); o.z = cvt_pk_bf16(s[4 * 33], s[5 * 33]); o.w = cvt_pk_bf16(s[6 * 33], s[7 * 33]);
        *(u32x4*)(WT + (size_t)(n0 + n) * K + k0 + 8 * c) = o; }
    asm volatile("s_waitcnt lgkmcnt(0)" ::: "memory");
}

__device__ __forceinline__ void norm_row_mod(const float* xrow, const float* sh, const float* sc, bf16_t* orow, int lane) {
    const f32x4* xr = (const f32x4*)xrow + lane;
    f32x4 v[4]; float s = 0.f;
#pragma unroll
    for (int j = 0; j < 4; ++j) { v[j] = xr[64 * j]; s += (v[j].x * v[j].x + v[j].y * v[j].y) + (v[j].z * v[j].z + v[j].w * v[j].w); }
    const float rstd = rsqrtf(wave_sum(s, lane) * (1.f / DM) + EPS);
    u32x2* o8 = (u32x2*)orow + lane;
#pragma unroll
    for (int j = 0; j < 4; ++j) { const f32x4 a = ((const f32x4*)sh)[lane + 64 * j], b = ((const f32x4*)sc)[lane + 64 * j];
        const f32x4 y = v[j] * rstd * (b + 1.0f) + a;
        u32x2 w; w.x = cvt_pk_bf16(y.x, y.y); w.y = cvt_pk_bf16(y.z, y.w); o8[64 * j] = w; }
}

typedef short v4i16_t __attribute__((ext_vector_type(4)));
__device__ __forceinline__ v4i16_t vtr(const LAS unsigned char* p) { return __builtin_amdgcn_ds_read_tr16_b64_v4i16((LAS v4i16_t*)p); }
template <int DQ, bool NOMAX>
__device__ __forceinline__ void attn_unit(LAS unsigned char* lds, const bf16_t* Qp, int ldq, const bf16_t* Kp, int ldk, const bf16_t* Kx, const bf16_t* Vp, int ldv,
                                          bf16_t* Op, int qrow0, int qpos0, int nkt, int kseg0_row, int kseg1_row, bool rope, float C_, const int tid) {
    float C = C_; asm volatile("" : "+v"(C));
    constexpr int KST = DQ * 2 + 16, BUFSZ = 64 * KST + 8192, NS = DQ / 16;
    const int lane = tid & 63, wave = __builtin_amdgcn_readfirstlane(tid >> 6), li = lane & 31, hi = lane >> 5;
    f32x16 O0, O1;
#pragma unroll
    for (int r = 0; r < 16; ++r) { O0[r] = 0.f; O1[r] = 0.f; }
    float mrun = -INFINITY, lrun = 0.f;
    const int skey = tid >> 3, sch = tid & 7;
    const int xkey = tid >> 3, xch = tid & 7;
    const int kwoff = skey * KST + sch * 16, xwoff = xkey * KST + 128 + xch * 8;
    const int vwoff = 64 * KST + (skey >> 2) * 512 + (sch >> 2) * 256 + (skey & 3) * 64 + (sch & 3) * 16;
    const int aoff = li * KST + hi * 16;
    const int vroff = 64 * KST + hi * 512 + ((lane & 15) >> 2) * 64 + ((lane >> 4) & 1) * 32 + (lane & 3) * 8;
    u32x4 kregA, vregA, kregB, vregB; u32x2 xregA, xregB;
#define ATT_GLOAD(t, KR, VR, XR) do { const int row_ = ((t) < 4 ? kseg0_row + 64 * (t) : kseg1_row + 64 * ((t) - 4)); \
        KR = *(const u32x4*)(Kp + (size_t)(row_ + skey) * ldk + 8 * sch); \
        VR = *(const u32x4*)(Vp + (size_t)(row_ + skey) * ldv + 8 * sch); \
        if constexpr (DQ == 96) { XR = *(const u32x2*)(Kx + (size_t)(row_ + xkey) * DINP + 4 * xch); } } while (0)
#define ATT_LSTORE(buf, KR, VR, XR) do { LAS unsigned char* B_ = lds + (buf) * BUFSZ; \
        *(LAS u32x4*)(B_ + kwoff) = KR; *(LAS u32x4*)(B_ + vwoff) = VR; \
        if constexpr (DQ == 96) { *(LAS u32x2*)(B_ + xwoff) = XR; } } while (0)
#define ATT_TILE(t, LK, LV, LX, SK, SV, SX) do { \
        if ((t) + 2 < nkt) ATT_GLOAD((t) + 2, LK, LV, LX); \
        const LAS unsigned char* Bb = lds + ((t) & 1) * BUFSZ; \
        bf16x8 kf0[NS], kf1[NS]; \
        _Pragma("unroll") for (int s = 0; s < NS; ++s) { kf0[s] = *(const LAS bf16x8*)(Bb + aoff + s * 32); kf1[s] = *(const LAS bf16x8*)(Bb + 32 * KST + aoff + s * 32); } \
        v4i16_t vl0[4], vh0[4], vl1[4], vh1[4]; \
        if constexpr (DQ == 64) { _Pragma("unroll") for (int ks = 0; ks < 4; ++ks) { const LAS unsigned char* vb = Bb + vroff + ks * 2048; vl0[ks] = vtr(vb); vh0[ks] = vtr(vb + 1024); vl1[ks] = vtr(vb + 256); vh1[ks] = vtr(vb + 1024 + 256); } } \
        __builtin_amdgcn_sched_barrier(0); \
        f32x16 S0, S1; \
        _Pragma("unroll") for (int r = 0; r < 16; ++r) { S0[r] = 0.f; S1[r] = 0.f; } \
        _Pragma("unroll") for (int s = 0; s < NS; ++s) { \
            S0 = __builtin_amdgcn_mfma_f32_32x32x16_bf16(kf0[s], qf[s], S0, 0, 0, 0); \
            S1 = __builtin_amdgcn_mfma_f32_32x32x16_bf16(kf1[s], qf[s], S1, 0, 0, 0); } \
        float ls0 = 0.f, ls1 = 0.f; \
        if constexpr (NOMAX) {     \
            _Pragma("unroll") for (int r = 0; r < 16; ++r) { S0[r] = fexp2(S0[r]); S1[r] = fexp2(S1[r]); ls0 += S0[r]; ls1 += S1[r]; } \
        } else { \
        float mxa = fmaxf(S0[0], S1[0]), mxb = fmaxf(S0[1], S1[1]); \
        _Pragma("unroll") for (int r = 2; r < 16; r += 2) { mxa = fmaxf(fmaxf(mxa, S0[r]), S1[r]); mxb = fmaxf(fmaxf(mxb, S0[r + 1]), S1[r + 1]); }     \
        float mx = fmaxf(mxa, mxb); \
        mx = fmaxf(mx, shx(mx, 32, lane)); \
        if (__builtin_amdgcn_ballot_w64(mx > mrun) != 0ull) { \
            const float mnew = fmaxf(mrun, mx); \
            const float alpha = fexp2((mrun - mnew) * C); \
            mrun = mnew; lrun *= alpha; \
            _Pragma("unroll") for (int r = 0; r < 16; ++r) { O0[r] *= alpha; O1[r] *= alpha; } } \
        const float mc = mrun * C; \
        _Pragma("unroll") for (int r = 0; r < 16; ++r) { S0[r] = fexp2(S0[r] * C - mc); S1[r] = fexp2(S1[r] * C - mc); ls0 += S0[r]; ls1 += S1[r]; } \
        } \
        lrun += ls0 + ls1; \
        if constexpr (DQ != 64) { __builtin_amdgcn_sched_barrier(0); _Pragma("unroll") for (int ks = 0; ks < 4; ++ks) { const LAS unsigned char* vb = Bb + vroff + ks * 2048; vl0[ks] = vtr(vb); vh0[ks] = vtr(vb + 1024); vl1[ks] = vtr(vb + 256); vh1[ks] = vtr(vb + 1024 + 256); } } \
        bf16x8 pb[4]; \
        _Pragma("unroll") for (int e = 0; e < 2; ++e) { u32x4 w0, w1; \
            w0.x = cvt_pk_bf16(S0[8 * e + 0], S0[8 * e + 1]); w0.y = cvt_pk_bf16(S0[8 * e + 2], S0[8 * e + 3]); w0.z = cvt_pk_bf16(S0[8 * e + 4], S0[8 * e + 5]); w0.w = cvt_pk_bf16(S0[8 * e + 6], S0[8 * e + 7]); \
            w1.x = cvt_pk_bf16(S1[8 * e + 0], S1[8 * e + 1]); w1.y = cvt_pk_bf16(S1[8 * e + 2], S1[8 * e + 3]); w1.z = cvt_pk_bf16(S1[8 * e + 4], S1[8 * e + 5]); w1.w = cvt_pk_bf16(S1[8 * e + 6], S1[8 * e + 7]); \
            pb[e] = __builtin_bit_cast(bf16x8, w0); pb[2 + e] = __builtin_bit_cast(bf16x8, w1); } \
        _Pragma("unroll") for (int ks = 0; ks < 4; ++ks) { \
            const bf16x8 a0 = __builtin_shufflevector(vl0[ks], vh0[ks], 0, 1, 2, 3, 4, 5, 6, 7), a1 = __builtin_shufflevector(vl1[ks], vh1[ks], 0, 1, 2, 3, 4, 5, 6, 7); \
            O0 = __builtin_amdgcn_mfma_f32_32x32x16_bf16(a0, pb[ks], O0, 0, 0, 0); \
            O1 = __builtin_amdgcn_mfma_f32_32x32x16_bf16(a1, pb[ks], O1, 0, 0, 0); } \
        if ((t) + 1 < nkt) ATT_LSTORE(((t) + 1) & 1, SK, SV, SX); \
        __syncthreads(); } while (0)
    ATT_GLOAD(0, kregA, vregA, xregA); ATT_GLOAD(1, kregB, vregB, xregB);
    bf16x8 qf[NS];
    {
        const bf16_t* qrow = Qp + (size_t)(qrow0 + wave * 32 + li) * ldq;
#pragma unroll
        for (int s = 0; s < 4; ++s) qf[s] = *(const bf16x8*)(qrow + 16 * s + 8 * hi);
        if constexpr (DQ == 96 && NOMAX) {
#pragma unroll
            for (int s = 0; s < 4; ++s) { const u32x4 a = __builtin_bit_cast(u32x4, qf[s]); u32x4 w;
                w.x = cvt_pk_bf16(bflo(a.x) * C_, bfhi(a.x) * C_); w.y = cvt_pk_bf16(bflo(a.y) * C_, bfhi(a.y) * C_); w.z = cvt_pk_bf16(bflo(a.z) * C_, bfhi(a.z) * C_); w.w = cvt_pk_bf16(bflo(a.w) * C_, bfhi(a.w) * C_);
                qf[s] = __builtin_bit_cast(bf16x8, w); }
        }
        if constexpr (DQ == 96) {
            const int t = qpos0 + wave * 32 + li;
#pragma unroll
            for (int s = 4; s < 6; ++s) {
                const u32x4 a = *(const u32x4*)(qrow + 16 * s), b = *(const u32x4*)(qrow + 16 * s + 8);
                float x1[8] = {bflo(a.x), bfhi(a.x), bflo(a.y), bfhi(a.y), bflo(a.z), bfhi(a.z), bflo(a.w), bfhi(a.w)};
                float x2[8] = {bflo(b.x), bfhi(b.x), bflo(b.y), bfhi(b.y), bflo(b.z), bfhi(b.z), bflo(b.w), bfhi(b.w)};
                float y[8];
                const float pos = (float)(s == 4 ? (t >> 6) : (t & 63));
#pragma unroll
                for (int i = 0; i < 8; ++i) {
                    float cs = 1.f, sn = 0.f;
                    if (rope) { const float rev = pos * fexp2(-(float)i * (LOG2_ROPE / 8.f)) * INV_2PI; cs = __builtin_amdgcn_cosf(rev); sn = __builtin_amdgcn_sinf(rev); }
                    y[i] = hi ? (x1[i] * sn + x2[i] * cs) : (x1[i] * cs - x2[i] * sn);
                    if constexpr (NOMAX) y[i] *= C_;
                }
                u32x4 w; w.x = cvt_pk_bf16(y[0], y[1]); w.y = cvt_pk_bf16(y[2], y[3]); w.z = cvt_pk_bf16(y[4], y[5]); w.w = cvt_pk_bf16(y[6], y[7]);
                qf[s] = __builtin_bit_cast(bf16x8, w);
            }
        }
    }
    ATT_LSTORE(0, kregA, vregA, xregA);
    __syncthreads();
    for (int t = 0; t < nkt; t += 2) {
        ATT_TILE(t, kregA, vregA, xregA, kregB, vregB, xregB);
        ATT_TILE(t + 1, kregB, vregB, xregB, kregA, vregA, xregA);
    }
#undef ATT_TILE
#undef ATT_GLOAD
#undef ATT_LSTORE
    const float ltot = lrun + shx(lrun, 32, lane);
    const float rl = 1.0f / ltot;
    bf16_t* orow = Op + (size_t)(qrow0 + wave * 32 + li) * DM;
#pragma unroll
    for (int rg = 0; rg < 4; ++rg) {
        u32x2 w0, w1;
        w0.x = cvt_pk_bf16(O0[4 * rg] * rl, O0[4 * rg + 1] * rl); w0.y = cvt_pk_bf16(O0[4 * rg + 2] * rl, O0[4 * rg + 3] * rl);
        w1.x = cvt_pk_bf16(O1[4 * rg] * rl, O1[4 * rg + 1] * rl); w1.y = cvt_pk_bf16(O1[4 * rg + 2] * rl, O1[4 * rg + 3] * rl);
        *(u32x2*)(orow + 8 * rg + 4 * hi) = w0;
        *(u32x2*)(orow + 32 + 8 * rg + 4 * hi) = w1;
    }
}

__global__ void __launch_bounds__(512, 2) mega_fwd(Args a) {
    extern __shared__ __attribute__((aligned(16))) unsigned char lds_raw[];
    LAS unsigned char* lds = (LAS unsigned char*)lds_raw;
    cg::grid_group grid = cg::this_grid();
    const int G = gridDim.x; int bid = blockIdx.x;
    const int NGW = G * 8;
    const int wave0 = __builtin_amdgcn_readfirstlane((int)threadIdx.x >> 6);
    volatile LAS unsigned* bst = (volatile LAS unsigned*)(lds + 131072 + 64);
    if (threadIdx.x < 4) bst[threadIdx.x] = 0u;
    __syncthreads();
    XcdBarrier xbar; xbar.bar = (unsigned*)(a.ws + WS_CTL); xbar.x = xb_xcc_id(); xbar.st = bst;
    if (blockIdx.x == 0) { for (int i = threadIdx.x; i < (int)(CTL_BYTES / 4); i += 512) __hip_atomic_store(xbar.bar + i, 0u, __ATOMIC_RELAXED, __HIP_MEMORY_SCOPE_AGENT); }
    const bool thr0 = (threadIdx.x == 0);
#define GRID_BAR() xcd_barrier(xbar, thr0)
#define PHASE_IDS() int lane_; asm volatile("v_mbcnt_lo_u32_b32 %0, -1, 0\n\tv_mbcnt_hi_u32_b32 %0, -1, %0" : "=v"(lane_)); const int lane = lane_; const int wave = wave0; const int tid = wave * 64 + lane; const int gw = bid * 8 + wave; (void)lane; (void)gw; (void)tid; \
    const AS4 char* kp_ = (const AS4 char*)__builtin_amdgcn_kernarg_segment_ptr(); asm volatile("" : "+s"(kp_)); unsigned char* const ws = *(unsigned char* const AS4*)(kp_ + 200); (void)ws;
#define AS4 __attribute__((address_space(4)))
#define IN(i) (*(const float* const AS4*)(kp_ + 8 * (i)))
#define OUTP (*(float* const AS4*)(kp_ + 192))
#define MOD ((float*)(ws + WS_MOD))
#define WINT ((bf16_t*)(ws + WS_WIN))
#define WOUTT ((bf16_t*)(ws + WS_WOUT))
#define W1T ((bf16_t*)(ws + WS_W1))
#define W2T ((bf16_t*)(ws + WS_W2))
#define UQT ((bf16_t*)(ws + WS_UQ))
#define UKVT ((bf16_t*)(ws + WS_UKV))
#define PWT ((bf16_t*)(ws + WS_PW))
#define CX ((float*)(ws + WS_CX))
#define CKV ((float*)(ws + WS_CKV))
#define SPT ((bf16_t*)(ws + WS_SPT))
#define XN ((bf16_t*)(ws + WS_XN))
#define CA ((bf16_t*)(ws + WS_XN))
#define U ((bf16_t*)(ws + WS_U))
#define YCAT ((bf16_t*)(ws + WS_YCAT))
#define QM ((bf16_t*)(ws + WS_QM))
#define KVM ((bf16_t*)(ws + WS_KVM))
#define HB ((bf16_t*)(ws + WS_H))
#define modl (MOD + (size_t)l * 9 * NMOD)
#define xlat_in ((l == 0) ? IN(I_X) : OUTP)
#define xctx_in ((l == 0) ? IN(I_CTX) : CX)

    {
        PHASE_IDS();
        LAS float* sc = (LAS float*)lds;
        LAS float* red = sc + 9 * 1024;
        for (int i = tid; i < 9 * 1024; i += 512) { const float v = (i < 8192) ? IN(I_C)[i] : IN(I_CCTX)[i - 8192]; sc[i] = v * sigmoidf_(v); }
        if (bid == 0 && tid < DEPTH * 8) { const float dd = IN(I_RDEC)[tid]; MOD[DEPTH * 9 * NMOD + tid] = -log1pf(__expf(-dd)) * LOG2E; }
        __syncthreads();
        for (int item = bid; item < DEPTH * 48; item += G) {
            const int l = item / 48, n0 = (item % 48) * 128;
            const float* W = IN(I_WMOD) + (size_t)l * DM * NMOD + n0 + lane * 2;
            float acc[9][2];
#pragma unroll
            for (int j = 0; j < 9; ++j) { acc[j][0] = 0.f; acc[j][1] = 0.f; }
            for (int kk = 0; kk < 128; ++kk) {
                const int k = wave * 128 + kk; const f32x2 w = *(const f32x2*)(W + (size_t)k * NMOD);
#pragma unroll
                for (int j = 0; j < 9; ++j) { const float s = sc[j * 1024 + k]; acc[j][0] += s * w.x; acc[j][1] += s * w.y; }
            }
#pragma unroll
            for (int j = 0; j < 9; ++j) { red[(wave * 18 + j * 2) * 64 + lane] = acc[j][0]; red[(wave * 18 + j * 2 + 1) * 64 + lane] = acc[j][1]; }
            __syncthreads();
            for (int o = tid; o < 18 * 64; o += 512) {
                const int aidx = o >> 6, ln = o & 63; float s = 0.f;
#pragma unroll
                for (int w = 0; w < 8; ++w) s += red[(w * 18 + aidx) * 64 + ln];
                const int j = aidx >> 1, n = n0 + ln * 2 + (aidx & 1);
                MOD[((size_t)l * 9 + j) * NMOD + n] = s + IN(I_BMOD)[(size_t)l * NMOD + n];
            }
            __syncthreads();
        }
    }
    grid.sync();
    if (threadIdx.x == 0) { const unsigned jl = xb_add(&xbar.bar[XB_XCNT(xbar.x)], 1u); bst[2] = jl; }

    for (int l = 0; l < DEPTH; ++l) {
        const bool last = (l == DEPTH - 1);
        const int Mrows = last ? TL : TT;

        {
            PHASE_IDS();
            LAS float* scr = (LAS float*)(lds + wave * 16384);
            constexpr int IT_IN = 16 * 77, IT_OUT = 16 * 32, IT_W1 = 16 * 128, IT_W2 = 64 * 32, IT_UQ = 4 * 12, IT_UKV = 2 * 16, IT_PW = 4 * 8;
            constexpr int NIT = IT_IN + IT_OUT + IT_W1 + IT_W2 + IT_UQ + IT_UKV + IT_PW;
            for (int it = gw; it < NIT; it += NGW) {
                int r = it;
                if (r < IT_IN) { transpose_item(IN(I_WIN) + (size_t)l * DM * DIN, DM, DIN, WINT, scr, r, lane); continue; } r -= IT_IN;
                if (r < IT_OUT) { transpose_item(IN(I_WOUT) + (size_t)l * DM * DM, DM, DM, WOUTT, scr, r, lane); continue; } r -= IT_OUT;
                if (r < IT_W1) { transpose_item(IN(I_W1) + (size_t)l * DM * DFF, DM, DFF, W1T, scr, r, lane); continue; } r -= IT_W1;
                if (r < IT_W2) { transpose_item(IN(I_W2) + (size_t)l * DFF * DM, DFF, DM, W2T, scr, r, lane); continue; } r -= IT_W2;
                if (r < IT_UQ) { transpose_item(IN(I_MUQ) + (size_t)l * 256 * 384, 256, 384, UQT, scr, r, lane); continue; } r -= IT_UQ;
                if (r < IT_UKV) { transpose_item(IN(I_MUKV) + (size_t)l * 128 * 512, 128, 512, UKVT, scr, r, lane); continue; } r -= IT_UKV;
                transpose_item(IN(I_CPW) + (size_t)l * 256 * 256, 256, 256, PWT, scr, r, lane);
            }
            if (bid == 0 && tid < 168) ((unsigned*)(ws + WS_NB))[tid] = 0u;
            {
                const int gt = bid * 512 + tid, ngt = G * 512; unsigned zz = 0u; asm volatile("" : "+v"(zz)); const u32x4 z = {zz, zz, zz, zz};
                u32x4* p0 = (u32x4*)(WINT + (size_t)DIN * DM);
                for (int i = gt; i < (DINP - DIN) * DM / 8; i += ngt) p0[i] = z;
                u32x4* p1 = (u32x4*)(UQT + (size_t)384 * 256);
                for (int i = gt; i < 128 * 256 / 8; i += ngt) p1[i] = z;
            }
            for (int m = gw; m < TT; m += NGW) {
                const bool isl = m < TL; const int j = isl ? (m >> 12) : 8;
                if (!isl && l > 0) {
                    f32x4* cr = (f32x4*)(CX + (size_t)(m - TL) * DM) + lane;
                    const f32x4* pr = (const f32x4*)((const float*)(ws + WS_KVM) + (size_t)(m - TL) * DM) + lane;
                    const f32x4* gp = (const f32x4*)(MOD + (size_t)(l - 1) * 9 * NMOD + (size_t)8 * NMOD + 5 * DM) + lane;
#pragma unroll
                    for (int jj = 0; jj < 4; ++jj) {
                        const f32x4 p = (pr[64 * jj] + pr[64 * jj + (size_t)TC * DM / 4]) + (pr[64 * jj + 2 * (size_t)TC * DM / 4] + pr[64 * jj + 3 * (size_t)TC * DM / 4]);
                        cr[64 * jj] = cr[64 * jj] + gp[64 * jj] * p;
                    }
                    asm volatile("s_waitcnt vmcnt(0)" ::: "memory");
                }
                const float* xr = isl ? xlat_in + (size_t)m * DM : xctx_in + (size_t)(m - TL) * DM;
                norm_row_mod(xr, modl + (size_t)j * NMOD + 0 * DM, modl + (size_t)j * NMOD + 1 * DM, XN + (size_t)m * DM, lane);
            }
        }
        GRID_BAR();

        if (l == 0) {
            if (threadIdx.x == 0) {
                bool ok = (G == 256);
#pragma unroll
                for (unsigned jx = 0; jx < 16; ++jx) { const unsigned cnt = xb_ld(&xbar.bar[XB_XCNT(jx)]); ok = ok && (cnt == (jx < 8 ? 32u : 0u)); }
                bst[3] = ok ? (bst[2] * 8u + xbar.x) : (unsigned)blockIdx.x;
            }
            __syncthreads();
            bid = __builtin_amdgcn_readfirstlane((int)bst[3]);
        }

        {
            PHASE_IDS();
            pg8::Gemm g{XN, WINT, TT, DINP, DM, DM}; pg8::StaticOrder S; S.init(TT, DINP, G, bid, g.K);
            pg8::EpiBf16<0> E{U, DINP};
            for (int rep = 0; rep < PROBE_GEMM; ++rep)
            pg8::gemm_phase<pg8::EpiBf16<0>, pg8::StaticOrder>(lds, g, S, E, tid);
        }
        GRID_BAR();

        {
            PHASE_IDS();
            LAS float* glu = (LAS float*)lds;
            LAS float* dwl = glu + 94 * 256;
            const float* dw = IN(I_CDW) + (size_t)l * 31 * 256;
            for (int i = tid; i < 31 * 256; i += 512) dwl[i] = dw[i];
            const f32x4 cb4 = *(const f32x4*)(IN(I_CB) + l * 256 + 4 * lane), lg4 = *(const f32x4*)(IN(I_CLG) + l * 256 + 4 * lane), lb4 = *(const f32x4*)(IN(I_CLB) + l * 256 + 4 * lane);
            const f32x4 gq4 = *(const f32x4*)(IN(I_MQG) + l * 256 + 4 * lane);
            const f32x2 gkv2 = *(const f32x2*)(IN(I_MKVG) + l * 128 + 2 * lane);
            const int i16 = lane & 15;
            float gg_q[4], gg_k[4];
#pragma unroll
            for (int e = 0; e < 4; ++e) { gg_q[e] = IN(I_GQG)[l * 64 + 16 * e + i16]; gg_k[e] = IN(I_GKG)[l * 64 + 16 * e + i16]; }
            const float fr16 = fexp2(-(float)i16 * (LOG2_ROPE / 16.f)) * INV_2PI;
            const float fr8 = fexp2(-(float)(lane & 7) * (LOG2_ROPE / 8.f)) * INV_2PI;
            for (int tile = bid; tile < TT / 64; tile += G) {
                const int r0 = tile * 64;
                const int seq_lo = (r0 < TL) ? (r0 & ~4095) : (TL + ((r0 - TL) & ~255));
                const int seq_hi = (r0 < TL) ? seq_lo + 4096 : seq_lo + 256;
                u32x2 pva[12], pvg[12];
#pragma unroll
                for (int q = 0; q < 12; ++q) { const int it = tid + 512 * q; const int rr = it >> 6, c4 = (it & 63) * 4; const int row = r0 - 15 + rr;
                    pva[q] = (u32x2){0u, 0u}; pvg[q] = (u32x2){0u, 0u};
                    if (it < 94 * 64 && row >= seq_lo && row < seq_hi) { pva[q] = *(const u32x2*)(U + (size_t)row * DINP + C_A + c4); pvg[q] = *(const u32x2*)(U + (size_t)row * DINP + C_A + 256 + c4); } }
                __syncthreads();
#pragma unroll
                for (int q = 0; q < 12; ++q) { const int it = tid + 512 * q; const int rr = it >> 6, c4 = (it & 63) * 4;
                    if (it < 94 * 64) { const u32x2 va = pva[q], vg = pvg[q]; f32x4 gv;
                        gv.x = bflo(va.x) * sigmoidf_(bflo(vg.x)); gv.y = bfhi(va.x) * sigmoidf_(bfhi(vg.x)); gv.z = bflo(va.y) * sigmoidf_(bflo(vg.y)); gv.w = bfhi(va.y) * sigmoidf_(bfhi(vg.y));
                        *(LAS f32x4*)(glu + rr * 256 + c4) = gv; } }
                __syncthreads();
#pragma unroll 1
                for (int tg = 0; tg < 2; ++tg) {
                    const int tl0 = wave * 8 + tg * 4;
                    f32x4 acc4[4] = {cb4, cb4, cb4, cb4};
                    f32x4 dwin[4];
#pragma unroll
                    for (int k = 0; k < 4; ++k) dwin[k] = (f32x4){0.f, 0.f, 0.f, 0.f};
#pragma unroll
                    for (int r = 0; r < 34; ++r) {
                        const f32x4 gx = *(const LAS f32x4*)(glu + (tl0 + r) * 256 + 4 * lane);
#pragma unroll
                        for (int k = 3; k > 0; --k) dwin[k] = dwin[k - 1];
                        dwin[0] = (r < 31) ? *(const LAS f32x4*)(dwl + r * 256 + 4 * lane) : (f32x4){0.f, 0.f, 0.f, 0.f};
#pragma unroll
                        for (int k = 0; k < 4; ++k) if (r - k >= 0 && r - k < 31) acc4[k] += gx * dwin[k];
                    }
#pragma unroll
                    for (int k = 0; k < 4; ++k) {
                        const int row = r0 + tl0 + k; const f32x4 acc = acc4[k];
                        const float mean = wave_sum((acc.x + acc.y) + (acc.z + acc.w), lane) * (1.f / 256.f);
                        const f32x4 d = acc - mean;
                        const float var = wave_sum((d.x * d.x + d.y * d.y) + (d.z * d.z + d.w * d.w), lane) * (1.f / 256.f);
                        f32x4 y = d * rsqrtf(var + EPS) * lg4 + lb4;
                        y.x *= sigmoidf_(y.x); y.y *= sigmoidf_(y.y); y.z *= sigmoidf_(y.z); y.w *= sigmoidf_(y.w);
                        u32x2 w2; w2.x = cvt_pk_bf16(y.x, y.y); w2.y = cvt_pk_bf16(y.z, y.w);
                        *(u32x2*)(CA + (size_t)row * 256 + 4 * lane) = w2;
                    }
                }
                float kpe2 = 0.f;
#pragma unroll 4
                for (int tk = 0; tk < 8; ++tk) {
                    const int tl = wave * 8 + tk; const int row = r0 + tl;
                    bf16_t* ur = U + (size_t)row * DINP;
                    const bool isl = row < TL; const int tpos = row & 4095;
                    const float prow = (float)(tpos >> 6), pcol = (float)(tpos & 63);
                    {
                        const u32x2 v = *(const u32x2*)(ur + C_CQ + 4 * lane);
                        f32x4 x = {bflo(v.x), bfhi(v.x), bflo(v.y), bfhi(v.y)};
                        const float rs = rsqrtf(wave_sum((x.x * x.x + x.y * x.y) + (x.z * x.z + x.w * x.w), lane) * (1.f / 256.f) + EPS);
                        x = x * rs * gq4;
                        u32x2 w2; w2.x = cvt_pk_bf16(x.x, x.y); w2.y = cvt_pk_bf16(x.z, x.w);
                        *(u32x2*)(ur + C_CQ + 4 * lane) = w2;
                    }
                    {
                        const unsigned v = *(const unsigned*)(ur + C_CKV + 2 * lane);
                        float x0 = bflo(v), x1 = bfhi(v);
                        const float rs = rsqrtf(wave_sum(x0 * x0 + x1 * x1, lane) * (1.f / 128.f) + EPS);
                        *(unsigned*)(ur + C_CKV + 2 * lane) = cvt_pk_bf16(x0 * rs * gkv2.x, x1 * rs * gkv2.y);
                    }
                    {
                        const int blk = (lane >> 3) & 1, i = lane & 7;
                        bf16_t* p = ur + C_KPE + 16 * blk + i;
                        const float x1 = bf1(p[0]), x2 = bf1(p[8]);
                        kpe2 = fmaxf(kpe2, (lane < 16) ? (x1 * x1 + x2 * x2) : 0.f);
                        if (isl && lane < 16) {
                            const float rev = (blk ? pcol : prow) * fr8;
                            const float cs = __builtin_amdgcn_cosf(rev), sn = __builtin_amdgcn_sinf(rev);
                            p[0] = f2bf(x1 * cs - x2 * sn); p[8] = f2bf(x1 * sn + x2 * cs);
                        }
                    }
#pragma unroll
                    for (int pass = 0; pass < 2; ++pass) {
                        const int hd = lane >> 4;
                        const bool act = (pass == 0) || (lane < 32);
                        bf16_t* p = ur + (pass == 0 ? C_GQ : C_GK) + (act ? hd : 0) * 64 + i16;
                        float x0 = bf1(p[0]), x1 = bf1(p[16]), x2 = bf1(p[32]), x3 = bf1(p[48]);
                        const float rs = rsqrtf(sum16((x0 * x0 + x1 * x1) + (x2 * x2 + x3 * x3), lane) * (1.f / 64.f) + EPS);
                        if (pass == 0) { const float rq = rs * (0.125f * LOG2E); x0 *= rq * gg_q[0]; x1 *= rq * gg_q[1]; x2 *= rq * gg_q[2]; x3 *= rq * gg_q[3]; }
                        else { x0 *= rs * gg_k[0]; x1 *= rs * gg_k[1]; x2 *= rs * gg_k[2]; x3 *= rs * gg_k[3]; }
                        if (isl) {
                            const float rr = prow * fr16, rc = pcol * fr16;
                            const float c0 = __builtin_amdgcn_cosf(rr), s0 = __builtin_amdgcn_sinf(rr), c1 = __builtin_amdgcn_cosf(rc), s1 = __builtin_amdgcn_sinf(rc);
                            const float y0 = x0 * c0 - x1 * s0, y1 = x0 * s0 + x1 * c0, y2 = x2 * c1 - x3 * s1, y3 = x2 * s1 + x3 * c1;
                            x0 = y0; x1 = y1; x2 = y2; x3 = y3;
                        }
                        if (act) { p[0] = f2bf(x0); p[16] = f2bf(x1); p[32] = f2bf(x2); p[48] = f2bf(x3); }
                    }
                }
                { const float k2 = wave_sum(kpe2, lane) * 1.02f; const int bb = (r0 < TL) ? (r0 >> 12) : ((r0 - TL) >> 8);
                  if (lane == 0) atomicMax((unsigned*)(ws + WS_NB) + 160 + bb, __float_as_uint(k2)); }
            }
            __syncthreads();
            {
                LAS unsigned char* KF = lds;
                LAS unsigned char* KB = lds + 8192;
                LAS unsigned char* VS = lds + 16384;
                const int li = lane & 31, hi = lane >> 5;
                for (int u = (bid + 192) % G; u < NB * 4 * 34; u += G) {
                    const int b = u / 136, h = (u / 34) & 3, c = u % 34;
                    const int rowbase = (c < 2) ? TL + b * 256 + c * 128 : b * 4096 + (c - 2) * 128;
                    const float lgf2 = MOD[DEPTH * 9 * NMOD + l * 8 + h], lgb2 = MOD[DEPTH * 9 * NMOD + l * 8 + 4 + h];
                    const float kscale = 0.17677669529663687f;
                    __syncthreads();
                    {
                        const int j = tid >> 2, part = tid & 3;
                        const u32x4 kv = *(const u32x4*)(U + (size_t)(rowbase + j) * DINP + C_RK + h * 32 + part * 8);
                        const float wf = fexp2(lgf2 * (float)(127 - j)) * kscale, wb = fexp2(lgb2 * (float)j) * kscale;
                        u32x4 f, g;
                        f.x = cvt_pk_bf16(bflo(kv.x) * wf, bfhi(kv.x) * wf); f.y = cvt_pk_bf16(bflo(kv.y) * wf, bfhi(kv.y) * wf); f.z = cvt_pk_bf16(bflo(kv.z) * wf, bfhi(kv.z) * wf); f.w = cvt_pk_bf16(bflo(kv.w) * wf, bfhi(kv.w) * wf);
                        g.x = cvt_pk_bf16(bflo(kv.x) * wb, bfhi(kv.x) * wb); g.y = cvt_pk_bf16(bflo(kv.y) * wb, bfhi(kv.y) * wb); g.z = cvt_pk_bf16(bflo(kv.z) * wb, bfhi(kv.z) * wb); g.w = cvt_pk_bf16(bflo(kv.w) * wb, bfhi(kv.w) * wb);
                        *(LAS u32x4*)(KF + j * 64 + part * 16) = f; *(LAS u32x4*)(KB + j * 64 + part * 16) = g;
#pragma unroll
                        for (int e = 0; e < 2; ++e) { const int cch = part * 2 + e;
                            const u32x4 vv = *(const u32x4*)(U + (size_t)(rowbase + j) * DINP + C_RV + h * 64 + 8 * cch);
                            *(LAS u32x4*)(VS + (j >> 2) * 512 + (cch >> 2) * 256 + (j & 3) * 64 + (cch & 3) * 16) = vv; }
                    }
                    __syncthreads();
                    if (wave < 4) {
                        const int dir = wave >> 1, dt = wave & 1;
                        const LAS unsigned char* Kd = dir ? KB : KF;
                        const int tro = ((lane & 15) >> 2) * 64 + ((lane >> 4) & 1) * 32 + (lane & 3) * 8;
                        f32x16 D;
#pragma unroll
                        for (int r = 0; r < 16; ++r) D[r] = 0.f;
#pragma unroll
                        for (int st = 0; st < 8; ++st) {
                            const int j0 = 16 * st + 8 * hi;
                            const v4i16_t a0 = vtr(Kd + j0 * 64 + tro), a1 = vtr(Kd + (j0 + 4) * 64 + tro);
                            const v4i16_t b0 = vtr(VS + (j0 >> 2) * 512 + dt * 256 + tro), b1 = vtr(VS + ((j0 >> 2) + 1) * 512 + dt * 256 + tro);
                            const bf16x8 af = __builtin_shufflevector(a0, a1, 0, 1, 2, 3, 4, 5, 6, 7), bfv = __builtin_shufflevector(b0, b1, 0, 1, 2, 3, 4, 5, 6, 7);
                            D = __builtin_amdgcn_mfma_f32_32x32x16_bf16(af, bfv, D, 0, 0, 0);
                        }
                        float* outp = CKV + ((size_t)u * 2 + dir) * 2048 + 32 * dt + li;
#pragma unroll
                        for (int r = 0; r < 16; ++r) outp[crow(r, hi) * 64] = D[r];
                    }
                }
            }
        }
        GRID_BAR();

        {
            PHASE_IDS();
            {
                const int gt = bid * 512 + tid;
                if (gt < 64 * 2048) {
                    const int chain = gt >> 11, e = gt & 2047, dir = chain & 1, bh = chain >> 1, h = bh & 3;
                    const float g128 = fexp2(MOD[DEPTH * 9 * NMOD + l * 8 + dir * 4 + h] * 128.f);
                    const int dk = e >> 6, d = e & 63;
                    float s = 0.f; float cv[34];
#pragma unroll
                    for (int p = 0; p < 34; ++p) {
                        const int c = (dir == 0) ? p : (p < 2 ? 1 - p : 35 - p);
                        cv[p] = CKV[(((size_t)(bh * 34 + c)) * 2 + dir) * 2048 + e];
                    }
#pragma unroll
                    for (int p = 0; p < 34; ++p) {
                        const int c = (dir == 0) ? p : (p < 2 ? 1 - p : 35 - p);
                        const size_t ud = ((size_t)(bh * 34 + c)) * 2 + dir;
                        SPT[ud * 2048 + d * 32 + dk] = f2bf(s);
                        s = s * g128 + cv[p];
                    }
                }
            }
            {
                pg8::Gemm g{CA, PWT, Mrows, 256, 256, 256}; pg8::StaticOrder S; S.init(Mrows, 256, G, bid, g.K);
                pg8::EpiBf16<0> E{YCAT, DM};
                pg8::gemm_phase<pg8::EpiBf16<0>, pg8::StaticOrder>(lds, g, S, E, tid);
            }
            {
                pg8::Gemm g{U + C_CQ, UQT, Mrows, 512, 256, DINP}; pg8::StaticOrder S; S.init(Mrows, 512, G, (bid + 120) % G, g.K);
                pg8::EpiBf16N<0> E{QM, 512, (unsigned*)(ws + WS_NB)};
                pg8::gemm_phase<pg8::EpiBf16N<0>, pg8::StaticOrder>(lds, g, S, E, tid);
            }
            {
                pg8::Gemm g{U + C_CKV, UKVT, TT, 512, 128, DINP}; pg8::StaticOrder S; S.init(TT, 512, G, (bid + 104) % G, g.K);
                pg8::EpiBf16N<1> E{KVM, 512, (unsigned*)(ws + WS_NB)};
                pg8::gemm_phase<pg8::EpiBf16N<1>, pg8::StaticOrder>(lds, g, S, E, tid);
            }
        }
        GRID_BAR();

        {
            PHASE_IDS();
            const float C_MLA = 0.10206207261596575f * LOG2E;
            const unsigned* nbp = (const unsigned*)(ws + WS_NB);
#define mla_safe(b_, h_) (__builtin_amdgcn_readfirstlane(__float_as_int(sqrtf((__uint_as_float(nbp[((b_) * 4 + (h_)) * 3]) + __uint_as_float(nbp[((b_) * 4 + (h_)) * 3 + 1]) + __uint_as_float(nbp[((b_) * 4 + (h_)) * 3 + 2])) * \
        (__uint_as_float(nbp[96 + ((b_) * 4 + (h_)) * 2]) + __uint_as_float(nbp[96 + ((b_) * 4 + (h_)) * 2 + 1]) + __uint_as_float(nbp[160 + (b_)]))) * C_MLA)) < __float_as_int(60.0f))
            bool gqa_safe;
            { float gq = fabsf(IN(I_GQG)[l * 64 + lane]), gk = fabsf(IN(I_GKG)[l * 64 + lane]);
#pragma unroll
              for (int o = 1; o < 64; o <<= 1) { gq = fmaxf(gq, shx(gq, o, lane)); gk = fmaxf(gk, shx(gk, o, lane)); }
              gqa_safe = __builtin_amdgcn_readfirstlane(__float_as_int(8.0f * gq * gk * LOG2E)) < __float_as_int(60.0f); }
            for (int rep = 0; rep < PROBE_ATT; ++rep) {
                const int xcd = bid & 7, j = bid >> 3;
                const int nm = 2 + ((!last && bid < 32) ? 1 : 0), ng = 2 + ((!last && bid >= 32 && bid < 64) ? 1 : 0);
#pragma unroll 1
                for (int r = 0; r < nm; ++r) {
                    const bool cx = (r == 2);
                    const int stream = xcd * 4 + (r & 1) * 2 + (j >> 4), b = cx ? (bid >> 2) : (stream >> 2), h = cx ? (bid & 3) : (stream & 3), qb = j & 15;
                    const int qrow0 = cx ? TL + b * 256 : b * 4096 + qb * 256, qpos0 = cx ? 0 : qb * 256, nkt = cx ? 4 : 68;
                    if (mla_safe(b, h)) attn_unit<96, true>(lds, QM + h * 96, 512, KVM + h * 128, 512, U + C_KPE, KVM + h * 128 + 64, 512, YCAT + 256 + h * 64, qrow0, qpos0, nkt, TL + b * 256, b * 4096, !cx, C_MLA, tid);
                    else attn_unit<96, false>(lds, QM + h * 96, 512, KVM + h * 128, 512, U + C_KPE, KVM + h * 128 + 64, 512, YCAT + 256 + h * 64, qrow0, qpos0, nkt, TL + b * 256, b * 4096, !cx, C_MLA, tid);
                }
#pragma unroll 1
                for (int r = 0; r < ng; ++r) {
                    const bool cx = (r == 2);
                    const int stream = xcd * 2 + (r & 1), bh = bid & 31;
                    const int b = cx ? (bh >> 2) : (stream >> 1), kvh = cx ? ((bh & 3) >> 1) : (stream & 1), h = cx ? (bh & 3) : kvh * 2 + (j >> 4), qb = j & 15;
                    const int qrow0 = cx ? TL + b * 256 : b * 4096 + qb * 256, qpos0 = cx ? 0 : qb * 256, nkt = cx ? 4 : 68;
                    if (gqa_safe) attn_unit<64, true>(lds, U + C_GQ + h * 64, DINP, U + C_GK + kvh * 64, DINP, nullptr, U + C_GV + kvh * 64, DINP, YCAT + 512 + h * 64, qrow0, qpos0, nkt, TL + b * 256, b * 4096, !cx, 1.0f, tid);
                    else attn_unit<64, false>(lds, U + C_GQ + h * 64, DINP, U + C_GK + kvh * 64, DINP, nullptr, U + C_GV + kvh * 64, DINP, YCAT + 512 + h * 64, qrow0, qpos0, nkt, TL + b * 256, b * 4096, !cx, 1.0f, tid);
                }
            }
            {
                PHASE_IDS();
                constexpr int VS2 = 264;
                LAS unsigned char* VT = lds;
                LAS float* YX = (LAS float*)(lds + 17408);
                const int c0 = last ? 2 : 0, nC = 34 - c0, nU = NB * 4 * nC;
                const int li = lane & 31, hi = lane >> 5, qg = wave & 3, dir = wave >> 2;
                for (int uu = (bid + 192) % G; uu < nU; uu += G) {
                    const int b = uu / (4 * nC), h = (uu / nC) & 3, c = c0 + uu % nC;
                    const int rowbase = (c < 2) ? TL + b * 256 + c * 128 : b * 4096 + (c - 2) * 128;
                    const float lg2 = MOD[DEPTH * 9 * NMOD + l * 8 + dir * 4 + h];
                    const float kscale = 0.17677669529663687f;
                    u32x4 vst[2];
#pragma unroll
                    for (int e = 0; e < 2; ++e) { const int idx = tid + 512 * e, key = idx >> 3, dch = idx & 7;
                        vst[e] = *(const u32x4*)(U + (size_t)(rowbase + key) * DINP + C_RV + h * 64 + 8 * dch); }
                    const int qi = 32 * qg + li; const size_t rowi = (size_t)(rowbase + qi);
                    bf16x8 qf[2];
#pragma unroll
                    for (int s = 0; s < 2; ++s) qf[s] = *(const bf16x8*)(U + rowi * DINP + C_RQ + h * 32 + 16 * s + 8 * hi);
                    bf16x8 kfa[4][2], spf[2][2]; u32x2 gtv[8];
#pragma unroll
                    for (int jt = 0; jt < 4; ++jt)
#pragma unroll
                        for (int s = 0; s < 2; ++s) kfa[jt][s] = *(const bf16x8*)(U + (size_t)(rowbase + 32 * jt + li) * DINP + C_RK + h * 32 + 16 * s + 8 * hi);
                    { const bf16_t* sp = SPT + ((((size_t)(b * 4 + h) * 34 + c) * 2 + dir) * 2048);
#pragma unroll
                      for (int s = 0; s < 2; ++s) { spf[0][s] = *(const bf16x8*)(sp + li * 32 + 16 * s + 8 * hi); spf[1][s] = *(const bf16x8*)(sp + (32 + li) * 32 + 16 * s + 8 * hi); } }
                    { const bf16_t* gp0 = U + rowi * DINP + (dir == 0 ? C_GF : C_GB) + h * 64;
#pragma unroll
                      for (int dt = 0; dt < 2; ++dt)
#pragma unroll
                          for (int rg = 0; rg < 4; ++rg) gtv[dt * 4 + rg] = *(const u32x2*)(gp0 + 32 * dt + 8 * rg + 4 * hi); }
                    f32x4 gnv[8];
                    { const float* ng0 = IN(I_RNG) + ((size_t)(l * 2 + dir) * 4 + h) * 64;
#pragma unroll
                      for (int dt = 0; dt < 2; ++dt)
#pragma unroll
                          for (int rg = 0; rg < 4; ++rg) gnv[dt * 4 + rg] = *(const f32x4*)(ng0 + 32 * dt + 8 * rg + 4 * hi); }
                    __syncthreads();
#pragma unroll
                    for (int e = 0; e < 2; ++e) { const int idx = tid + 512 * e, key = idx >> 3, dch = idx & 7;
                        *(LAS u32x4*)(VT + (key >> 2) * 512 + (dch >> 2) * 256 + (key & 3) * 64 + (dch & 3) * 16) = vst[e]; }
                    __syncthreads();
                    f32x16 O0, O1;
#pragma unroll
                    for (int r = 0; r < 16; ++r) { O0[r] = 0.f; O1[r] = 0.f; }
#pragma unroll
                    for (int jt = 0; jt < 4; ++jt) {
                        if (dir == 0 ? (jt > qg) : (jt < qg)) continue;
                        f32x16 S;
#pragma unroll
                        for (int r = 0; r < 16; ++r) S[r] = 0.f;
#pragma unroll
                        for (int s = 0; s < 2; ++s) {
                            S = __builtin_amdgcn_mfma_f32_32x32x16_bf16(kfa[jt][s], qf[s], S, 0, 0, 0);
                        }
#pragma unroll
                        for (int r = 0; r < 16; ++r) {
                            const int j = 32 * jt + crow(r, hi);
                            const int diff = (dir == 0) ? (qi - j) : (j - qi);
                            const float w = (diff >= 0) ? fexp2(lg2 * (float)diff) * kscale : 0.f;
                            S[r] *= w;
                        }
#pragma unroll
                        for (int e = 0; e < 2; ++e) {
                            u32x4 w0;
                            w0.x = cvt_pk_bf16(S[8 * e + 0], S[8 * e + 1]); w0.y = cvt_pk_bf16(S[8 * e + 2], S[8 * e + 3]); w0.z = cvt_pk_bf16(S[8 * e + 4], S[8 * e + 5]); w0.w = cvt_pk_bf16(S[8 * e + 6], S[8 * e + 7]);
                            const bf16x8 pb = __builtin_bit_cast(bf16x8, w0);
                            const int ks = 2 * jt + e;
                            const LAS unsigned char* vb = VT + hi * 512 + ((lane & 15) >> 2) * 64 + ((lane >> 4) & 1) * 32 + (lane & 3) * 8 + ks * 2048;
                            const v4i16_t l0 = vtr(vb), h0 = vtr(vb + 1024), l1 = vtr(vb + 256), h1 = vtr(vb + 1024 + 256);
                            const bf16x8 a0 = __builtin_shufflevector(l0, h0, 0, 1, 2, 3, 4, 5, 6, 7), a1 = __builtin_shufflevector(l1, h1, 0, 1, 2, 3, 4, 5, 6, 7);
                            O0 = __builtin_amdgcn_mfma_f32_32x32x16_bf16(a0, pb, O0, 0, 0, 0);
                            O1 = __builtin_amdgcn_mfma_f32_32x32x16_bf16(a1, pb, O1, 0, 0, 0);
                        }
                    }
                    {
                        f32x16 X0, X1;
#pragma unroll
                        for (int r = 0; r < 16; ++r) { X0[r] = 0.f; X1[r] = 0.f; }
#pragma unroll
                        for (int s = 0; s < 2; ++s) {
                            X0 = __builtin_amdgcn_mfma_f32_32x32x16_bf16(spf[0][s], qf[s], X0, 0, 0, 0);
                            X1 = __builtin_amdgcn_mfma_f32_32x32x16_bf16(spf[1][s], qf[s], X1, 0, 0, 0);
                        }
                        const float dec = fexp2(lg2 * (float)(dir == 0 ? qi + 1 : 128 - qi));
#pragma unroll
                        for (int r = 0; r < 16; ++r) { O0[r] += dec * X0[r]; O1[r] += dec * X1[r]; }
                    }
                    float ss = 0.f;
#pragma unroll
                    for (int r = 0; r < 16; ++r) ss += O0[r] * O0[r] + O1[r] * O1[r];
                    ss += shx(ss, 32, lane);
                    const float rs = rsqrtf(ss * (1.f / 64.f) + EPS);
                    const float* ng = IN(I_RNG) + ((size_t)(l * 2 + dir) * 4 + h) * 64;
                    f32x4 yv[8];
#pragma unroll
                    for (int dt = 0; dt < 2; ++dt)
#pragma unroll
                        for (int rg = 0; rg < 4; ++rg) {
                            const int d0 = 32 * dt + 8 * rg + 4 * hi;
                            const u32x2 gt2 = gtv[dt * 4 + rg]; const f32x4 gn = gnv[dt * 4 + rg];
                            const float g0 = bflo(gt2.x), g1 = bfhi(gt2.x), g2 = bflo(gt2.y), g3 = bfhi(gt2.y);
                            f32x4 y;
                            if (dt == 0) { y.x = O0[4 * rg]; y.y = O0[4 * rg + 1]; y.z = O0[4 * rg + 2]; y.w = O0[4 * rg + 3]; }
                            else { y.x = O1[4 * rg]; y.y = O1[4 * rg + 1]; y.z = O1[4 * rg + 2]; y.w = O1[4 * rg + 3]; }
                            y = y * rs * gn;
                            y.x *= g0 * sigmoidf_(g0); y.y *= g1 * sigmoidf_(g1); y.z *= g2 * sigmoidf_(g2); y.w *= g3 * sigmoidf_(g3);
                            yv[dt * 4 + rg] = y;
                        }
                    if (dir == 1) {
#pragma unroll
                        for (int dt = 0; dt < 2; ++dt)
#pragma unroll
                            for (int rg = 0; rg < 4; ++rg) *(LAS f32x4*)(YX + qi * 64 + 32 * dt + 8 * rg + 4 * hi) = yv[dt * 4 + rg];
                    }
                    __syncthreads();
                    if (dir == 0) {
                        bf16_t* yo = YCAT + rowi * DM + 768 + h * 64;
#pragma unroll
                        for (int dt = 0; dt < 2; ++dt)
#pragma unroll
                            for (int rg = 0; rg < 4; ++rg) {
                                const int d0 = 32 * dt + 8 * rg + 4 * hi;
                                const f32x4 y = yv[dt * 4 + rg] + *(const LAS f32x4*)(YX + qi * 64 + d0);
                                u32x2 w2; w2.x = cvt_pk_bf16(y.x, y.y); w2.y = cvt_pk_bf16(y.z, y.w);
                                *(u32x2*)(yo + d0) = w2;
                            }
                    }
                }
                __syncthreads();
            }
        }
        GRID_BAR();

        {
            PHASE_IDS();
            pg8::Gemm g{YCAT, WOUTT, Mrows, DM, DM, DM}; pg8::StaticOrder S; S.init(Mrows, DM, G, bid, g.K);
            pg8::EpiRes E{xlat_in, xctx_in, OUTP, CX, modl + 2 * DM, nullptr};
            pg8::gemm_phase<pg8::EpiRes, pg8::StaticOrder>(lds, g, S, E, tid);
        }
        GRID_BAR();

        { PHASE_IDS();
        for (int rep = 0; rep < PROBE_AUX; ++rep)
        for (int m = gw; m < Mrows; m += NGW) {
            const bool isl = m < TL; const int j = isl ? (m >> 12) : 8;
            const float* xr = isl ? OUTP + (size_t)m * DM : CX + (size_t)(m - TL) * DM;
            norm_row_mod(xr, modl + (size_t)j * NMOD + 3 * DM, modl + (size_t)j * NMOD + 4 * DM, XN + (size_t)m * DM, lane);
        }
        }
        GRID_BAR();

        {
            PHASE_IDS();
            pg8::Gemm g{XN, W1T, Mrows, DFF, DM, DM}; pg8::StaticOrder S; S.init(Mrows, DFF, G, bid, g.K);
            pg8::EpiBf16<1> E{HB, DFF};
            for (int rep = 0; rep < PROBE_GEMM; ++rep)
            pg8::gemm_phase<pg8::EpiBf16<1>, pg8::StaticOrder>(lds, g, S, E, tid);
        }
        GRID_BAR();

        {
            PHASE_IDS();
            pg8::Gemm g{HB, W2T, Mrows, DM, DFF, DFF}; pg8::StaticOrder S; S.init(TL, DM, G, bid, g.K);
            if (!last) S.extra(TL / 256, TC / 256, 4);
            pg8::EpiRes E{OUTP, CX, OUTP, CX, modl + 5 * DM, last ? (float*)nullptr : (float*)(ws + WS_KVM)};
            pg8::gemm_phase<pg8::EpiRes, pg8::StaticOrder>(lds, g, S, E, tid);
        }
        GRID_BAR();
    }

    { PHASE_IDS();
    for (int m = gw; m < TL; m += NGW) {
        f32x4* xr = (f32x4*)(OUTP + (size_t)m * DM) + lane;
        f32x4 v[4]; float s = 0.f;
#pragma unroll
        for (int j = 0; j < 4; ++j) { v[j] = xr[64 * j]; s += (v[j].x * v[j].x + v[j].y * v[j].y) + (v[j].z * v[j].z + v[j].w * v[j].w); }
        const float rstd = rsqrtf(wave_sum(s, lane) * (1.f / DM) + EPS);
#pragma unroll
        for (int j = 0; j < 4; ++j) xr[64 * j] = v[j] * rstd * ((const f32x4*)IN(I_FG))[lane + 64 * j];
    }
    }
}

extern "C" void kernel_launch(void* const* d_in, const int* in_sizes, int n_in, void* d_out, int out_size, void* d_ws, size_t ws_size, hipStream_t stream) {
    static int grid = 0;
    if (grid == 0) {
        int dev = 0, cus = 0, per_cu = 0;
        (void)hipGetDevice(&dev);
        (void)hipDeviceGetAttribute(&cus, hipDeviceAttributeMultiprocessorCount, dev);
        (void)hipFuncSetAttribute((const void*)mega_fwd, hipFuncAttributeMaxDynamicSharedMemorySize, LDS_BYTES);
        (void)hipOccupancyMaxActiveBlocksPerMultiprocessor(&per_cu, (const void*)mega_fwd, 512, LDS_BYTES);
        if (per_cu < 1) per_cu = 1;
        grid = cus * per_cu;
        if (grid != 256) fprintf(stderr, "kernel_launch: grid %d (expected 256)\n", grid);
        if (ws_size < WS_END || n_in != 24) { fprintf(stderr, "kernel_launch: ws %zu < %zu or n_in %d\n", ws_size, (size_t)WS_END, n_in); grid = -1; }
    }
    if (grid < 0) return;
    Args a{};
    for (int i = 0; i < 24; ++i) a.in[i] = (const float*)d_in[i];
    a.out = (float*)d_out; a.ws = (unsigned char*)d_ws;
    void* args[] = {&a};
    hipError_t e = hipLaunchCooperativeKernel((const void*)mega_fwd, dim3(grid), dim3(512), args, LDS_BYTES, stream);
    if (e != hipSuccess) fprintf(stderr, "cooperative launch failed: %s (grid %d)\n", hipGetErrorString(e), grid);
}
```

```cpp
#include <hip/hip_runtime.h>
#include <hip/hip_cooperative_groups.h>
#include <cstdio>
#include <cstdint>
namespace cg = cooperative_groups;
#ifndef PROBE_ATT
#define PROBE_ATT 1
#endif
#ifndef PROBE_GEMM
#define PROBE_GEMM 1
#endif
#ifndef PROBE_AUX
#define PROBE_AUX 1
#endif

#define LAS __attribute__((address_space(3)))
typedef unsigned short bf16_t;
typedef short bf16x8 __attribute__((ext_vector_type(8)));
typedef float f32x4 __attribute__((ext_vector_type(4)));
typedef float f32x2 __attribute__((ext_vector_type(2)));
typedef float f32x16 __attribute__((ext_vector_type(16)));
typedef unsigned u32x4 __attribute__((ext_vector_type(4)));
typedef unsigned u32x2 __attribute__((ext_vector_type(2)));

constexpr int NB = 8, SEQ = 4096, DM = 1024, DEPTH = 4, CTX = 256, DIN = 2464, DINP = 2560, DFF = 4096;
constexpr int TL = NB * SEQ, TC = NB * CTX, TT = TL + TC;
constexpr int NMOD = 6 * DM;
constexpr int C_A = 0, C_CQ = 512, C_CKV = 768, C_KPE = 896, C_GQ = 928, C_GK = 1184, C_GV = 1312, C_RQ = 1440, C_RK = 1568, C_RV = 1696, C_GF = 1952, C_GB = 2208;
constexpr float EPS = 1e-6f;
constexpr float LOG2_ROPE = 13.287712379549449f;
constexpr float INV_2PI = 0.15915494309189535f;
constexpr float LOG2E = 1.4426950408889634f;

constexpr size_t MiB = 1u << 20;
constexpr size_t WS_MOD = 0;
constexpr size_t WS_WIN = 1 * MiB;
constexpr size_t WS_WOUT = 6 * MiB;
constexpr size_t WS_W1 = 8 * MiB;
constexpr size_t WS_W2 = 16 * MiB;
constexpr size_t WS_UQ = 24 * MiB;
constexpr size_t WS_UKV = 24 * MiB + 256 * 1024;
constexpr size_t WS_PW = 24 * MiB + 512 * 1024;
constexpr size_t WS_CX = 25 * MiB;
constexpr size_t WS_CKV = 33 * MiB;
constexpr size_t WS_SPT = 51 * MiB;
constexpr size_t WS_XN = 60 * MiB;
constexpr size_t WS_U = 128 * MiB;
constexpr size_t WS_YCAT = 298 * MiB;
constexpr size_t WS_QM = 366 * MiB;
constexpr size_t WS_KVM = 400 * MiB;
constexpr size_t WS_H = 128 * MiB;
constexpr size_t WS_CTL = 434 * MiB;
constexpr size_t CTL_BYTES = 16384;
constexpr size_t WS_NB = WS_CTL + 32 * 1024;
constexpr size_t WS_END = 435 * MiB;

constexpr int LDS_BYTES = 131072 + 2048;

__device__ __forceinline__ unsigned cvt_pk_bf16(float lo, float hi) { unsigned r; asm volatile("v_cvt_pk_bf16_f32 %0, %1, %2" : "=v"(r) : "v"(lo), "v"(hi)); return r; }
__device__ __forceinline__ float bflo(unsigned w) { return __uint_as_float(w << 16); }
__device__ __forceinline__ float bfhi(unsigned w) { return __uint_as_float(w & 0xffff0000u); }
__device__ __forceinline__ float bf1(bf16_t h) { return __uint_as_float(((unsigned)h) << 16); }
__device__ __forceinline__ bf16_t f2bf(float f) { return (bf16_t)(cvt_pk_bf16(f, 0.f) & 0xffffu); }
__device__ __forceinline__ float shx(float v, int o, int lane) { return __int_as_float(__builtin_amdgcn_ds_bpermute((lane ^ o) << 2, __float_as_int(v))); }
__device__ __forceinline__ float wave_sum(float v, int lane) {
#pragma unroll
    for (int o = 1; o < 64; o <<= 1) v += shx(v, o, lane);
    return v;
}
__device__ __forceinline__ float sum16(float v, int lane) {
#pragma unroll
    for (int o = 1; o < 16; o <<= 1) v += shx(v, o, lane);
    return v;
}
__device__ __forceinline__ int crow(int r, int hi) { return (r & 3) + 8 * (r >> 2) + 4 * hi; }
__device__ __forceinline__ float sigmoidf_(float x) { return 1.0f / (1.0f + __expf(-x)); }
__device__ __forceinline__ float fexp2(float x) { return __builtin_amdgcn_exp2f(x); }

namespace pg8 {
constexpr int BM = 256, BK = 64, HALF = 128, HTB = HALF * BK * 2, STAGE_BYTES = 8 * HTB, NXCD = 8, WGM = 8;
__host__ __device__ __forceinline__ int lds_byte(int r, int c) { const int st = (r >> 4) * 2 + (c >> 5), rr = r & 15, cc = c & 31, ob = rr * 64 + cc * 2; return st * 1024 + (ob ^ (((ob >> 9) & 1) << 5)); }
__host__ __device__ __forceinline__ void stage_rc(int b, int& R, int& C) { const int st = b / 1024, sb = b % 1024, swz = sb ^ (((sb >> 9) & 1) << 5); R = (st >> 1) * 16 + swz / 64; C = (st & 1) * 32 + (swz % 64) / 2; }
__host__ __device__ __forceinline__ int perm32(int rho) { const int n = rho >> 4, i = rho & 15; return 8 * (i >> 2) + 4 * n + (i & 3); }

struct Unit { int pm, pn, koff, nt; };
struct Gemm { const bf16_t* A; const bf16_t* Bt; int M, N, K, lda; };

struct StaticOrder {
    int nM, nN, nwg, G, c, ntf, xt0, xnt, xsplit;
    __device__ __forceinline__ void init(int M, int N, int G_, int c_, int K) { nM = M / BM; nN = N / BM; nwg = nM * nN; G = G_; c = c_; ntf = K / BK; xt0 = 0; xnt = 0; xsplit = 1; }
    __device__ __forceinline__ void extra(int first_tile, int ntiles_m, int split) { xt0 = first_tile; xnt = ntiles_m * nN; xsplit = split; }
    __device__ __forceinline__ bool next(int i, Unit& u) const {
        const long L = (long)i * G + c;
        int pm, pn, koff = 0, nt = ntf;
        if (L >= nwg) {
            const int q = (int)(L - nwg); if (q >= xnt * xsplit) return false;
            const int tile = q / xsplit, ks = q % xsplit; pm = xt0 + tile / nN; pn = tile % nN; nt = ntf / xsplit; koff = ks * nt * BK;
        } else {
            int wgid = (int)L; { const int q = nwg / NXCD, r = nwg % NXCD, xcd = wgid % NXCD, off = wgid / NXCD; wgid = (xcd < r ? xcd * (q + 1) : r * (q + 1) + (xcd - r) * q) + off; }
            const int nig = WGM * nN, gid = wgid / nig, fm = gid * WGM, gsz = (nM - fm) < WGM ? (nM - fm) : WGM;
            pm = fm + ((wgid % nig) % gsz); pn = (wgid % nig) / gsz;
        }
        u.pm = pm; u.pn = pn; u.koff = koff; u.nt = nt; return true;
    }
};

template <int ACT  > struct EpiBf16 {
    static constexpr bool PERM = true;
    bf16_t* O; int ldc;
    __device__ __forceinline__ void operator()(const f32x4 (&acc)[2][2][4][2], const Unit& u, int wr, int wc, int fr, int fq) const {
        asm volatile("" : "+v"(fr), "+v"(fq));
        const int row0 = u.pm * BM + wr * 64 + fr; const int col0 = u.pn * BM + wc * 32 + 8 * fq;
#pragma unroll
        for (int ai = 0; ai < 2; ++ai)
#pragma unroll
            for (int m = 0; m < 4; ++m) { bf16_t* rowp = O + (size_t)(row0 + ai * HALF + m * 16) * ldc + col0;
#pragma unroll
                for (int bj = 0; bj < 2; ++bj) { f32x4 v0 = acc[ai][bj][m][0], v1 = acc[ai][bj][m][1];
                    if (ACT == 1) {
#pragma unroll
                        for (int e = 0; e < 4; ++e) { float a = fmaxf(v0[e], 0.f), b = fmaxf(v1[e], 0.f); v0[e] = a * a; v1[e] = b * b; } }
                    u32x4 w; w.x = cvt_pk_bf16(v0[0], v0[1]); w.y = cvt_pk_bf16(v0[2], v0[3]); w.z = cvt_pk_bf16(v1[0], v1[1]); w.w = cvt_pk_bf16(v1[2], v1[3]);
                    *(u32x4*)(rowp + bj * HALF) = w; } }
    }
};
template <int MODE  > struct EpiBf16N {
    static constexpr bool PERM = true;
    bf16_t* O; int ldc; unsigned* nb;
    __device__ __forceinline__ void operator()(const f32x4 (&acc)[2][2][4][2], const Unit& u, int wr, int wc, int fr, int fq) const {
        asm volatile("" : "+v"(fr), "+v"(fq));
        const int row0 = u.pm * BM + wr * 64 + fr; const int col0 = u.pn * BM + wc * 32 + 8 * fq;
        float mxs[2] = {0.f, 0.f};
#pragma unroll
        for (int ai = 0; ai < 2; ++ai)
#pragma unroll
            for (int m = 0; m < 4; ++m) { bf16_t* rowp = O + (size_t)(row0 + ai * HALF + m * 16) * ldc + col0;
#pragma unroll
                for (int bj = 0; bj < 2; ++bj) { const f32x4 v0 = acc[ai][bj][m][0], v1 = acc[ai][bj][m][1];
                    mxs[bj] = fmaxf(mxs[bj], ((v0[0] * v0[0] + v0[1] * v0[1]) + (v0[2] * v0[2] + v0[3] * v0[3])) + ((v1[0] * v1[0] + v1[1] * v1[1]) + (v1[2] * v1[2] + v1[3] * v1[3])));
                    u32x4 w; w.x = cvt_pk_bf16(v0[0], v0[1]); w.y = cvt_pk_bf16(v0[2], v0[3]); w.z = cvt_pk_bf16(v1[0], v1[1]); w.w = cvt_pk_bf16(v1[2], v1[3]);
                    *(u32x4*)(rowp + bj * HALF) = w; } }
        const int ln_ = fq * 16 + fr; const int b = (u.pm >= TL / BM) ? (u.pm - TL / BM) : (u.pm >> 4);
#pragma unroll
        for (int bj = 0; bj < 2; ++bj) {
            float v = mxs[bj];
            v += shx(v, 16, ln_); v += shx(v, 32, ln_);
#pragma unroll
            for (int o = 1; o < 16; o <<= 1) v = fmaxf(v, shx(v, o, ln_));
            const int cidx = 8 * u.pn + 4 * bj + wc;
            int slot = -1;
            if (MODE == 0) { if (cidx < 12) slot = (b * 4 + cidx / 3) * 3 + cidx % 3; }
            else { if ((cidx & 3) < 2) slot = 96 + (b * 4 + (cidx >> 2)) * 2 + (cidx & 3); }
            if (slot >= 0 && ln_ == 0) atomicMax(nb + slot, __float_as_uint(v * 1.02f));
        }
    }
};
struct EpiRes {
    static constexpr bool PERM = false;
    const float* base_lat; const float* base_ctx; float* out_lat; float* out_ctx; const float* gate;
    float* part;
    __device__ __forceinline__ void operator()(const f32x4 (&acc)[2][2][4][2], const Unit& u, int wr, int wc, int fr, int fq) const {
        asm volatile("" : "+v"(fr), "+v"(fq));
        const bool isctx = u.pm >= (TL / BM); const int j = isctx ? 8 : (u.pm >> 4);
        if (part && isctx) {
            const int ks = u.koff / (u.nt * BK);
            float* pp = part + ((size_t)ks * TC + (size_t)(u.pm - TL / BM) * BM) * DM + u.pn * BM + wc * 32 + 4 * fq;
#pragma unroll
            for (int ai = 0; ai < 2; ++ai)
#pragma unroll
                for (int m = 0; m < 4; ++m) { float* rp = pp + (size_t)(ai * HALF + wr * 64 + m * 16 + fr) * DM;
#pragma unroll
                    for (int bj = 0; bj < 2; ++bj)
#pragma unroll
                        for (int n = 0; n < 2; ++n) *(f32x4*)(rp + bj * HALF + n * 16) = acc[ai][bj][m][n]; }
            return;
        }
        const float* base = isctx ? base_ctx : base_lat; float* out = isctx ? out_ctx : out_lat;
        const int prow = isctx ? (u.pm - TL / BM) * BM : u.pm * BM;
        const float* g = gate + (size_t)j * NMOD;
        const int col0 = u.pn * BM + wc * 32 + 4 * fq;
        f32x4 gv[2][2];
#pragma unroll
        for (int bj = 0; bj < 2; ++bj)
#pragma unroll
            for (int n = 0; n < 2; ++n) gv[bj][n] = *(const f32x4*)(g + col0 + bj * HALF + n * 16);
#pragma unroll
        for (int ai = 0; ai < 2; ++ai) {
            f32x4 bs[4][2][2];
#pragma unroll
            for (int m = 0; m < 4; ++m) { const size_t off = (size_t)(prow + ai * HALF + wr * 64 + m * 16 + fr) * DM + col0;
#pragma unroll
                for (int bj = 0; bj < 2; ++bj)
#pragma unroll
                    for (int n = 0; n < 2; ++n) bs[m][bj][n] = *(const f32x4*)(base + off + bj * HALF + n * 16); }
            __builtin_amdgcn_sched_barrier(0);
#pragma unroll
            for (int m = 0; m < 4; ++m) { const size_t off = (size_t)(prow + ai * HALF + wr * 64 + m * 16 + fr) * DM + col0;
#pragma unroll
                for (int bj = 0; bj < 2; ++bj)
#pragma unroll
                    for (int n = 0; n < 2; ++n) *(f32x4*)(out + off + bj * HALF + n * 16) = bs[m][bj][n] + gv[bj][n] * acc[ai][bj][m][n]; }
            __builtin_amdgcn_sched_barrier(0);
        }
    }
};

template <class Epi, class Sched, bool ALIGN_EPI = true>
__device__ __forceinline__ void gemm_phase(LAS unsigned char* lds, const Gemm g, const Sched& S, const Epi& E, const int tid) {
    const int wid = __builtin_amdgcn_readfirstlane(tid >> 6), lane = tid & 63, wr = wid >> 2, wc = wid & 3, fr = lane & 15, fq = lane >> 4;
    const int K = g.K, lda = g.lda;
    unsigned voffA[2], voffB[2];
#define PG8_VOFFS(T_) do { _Pragma("unroll") for (int i = 0; i < 2; ++i) { int R, C; stage_rc((T_) * 16 + i * 8192, R, C); const int Rb = Epi::PERM ? ((R & ~31) + perm32(R & 31)) : R; \
        voffA[i] = (unsigned)(R * lda + C) * 2u; voffB[i] = (unsigned)(Rb * K + C) * 2u; } } while (0)
    PG8_VOFFS(tid);
    const size_t kstep = (size_t)(BK * 2);
    const size_t hstepA = (size_t)HALF * lda * 2, hstepB = (size_t)HALF * K * 2;
    const size_t tstepA = 2 * hstepA, tstepB = 2 * hstepB;
    const unsigned ldsw = (unsigned)wid * 1024u;
    int aoff = lds_byte(wr * 64 + fr, fq * 8), boff = lds_byte(wc * 32 + fr, fq * 8);
#define PG8_SA(b, h) (((b) * 2 + (h)) * HTB)
#define PG8_SB(b, h) ((4 + (b) * 2 + (h)) * HTB)
#define PG8_STAGE(bufoff, gbase, voff) do { _Pragma("unroll") for (int _i = 0; _i < 2; ++_i) \
        __builtin_amdgcn_global_load_lds((const unsigned*)((const char*)(gbase) + (voff)[_i]), (LAS unsigned*)(lds + (bufoff) + ldsw + _i * 8192), 16, 0, 0); } while (0)
#define PG8_LDA(dst, b, h) do { _Pragma("unroll") for (int m = 0; m < 4; ++m) _Pragma("unroll") for (int k = 0; k < 2; ++k) dst[m][k] = *(const LAS bf16x8*)(lds + PG8_SA(b, h) + aoff + m * 2048 + k * 1024); } while (0)
#define PG8_LDB(dst, b, h) do { _Pragma("unroll") for (int n = 0; n < 2; ++n) _Pragma("unroll") for (int k = 0; k < 2; ++k) dst[n][k] = *(const LAS bf16x8*)(lds + PG8_SB(b, h) + boff + n * 2048 + k * 1024); } while (0)
#define PG8_MMA(ai, bj, At, Bt) do { __builtin_amdgcn_s_setprio(1); _Pragma("unroll") for (int m = 0; m < 4; ++m) _Pragma("unroll") for (int n = 0; n < 2; ++n) _Pragma("unroll") for (int k = 0; k < 2; ++k) \
        acc[ai][bj][m][n] = __builtin_amdgcn_mfma_f32_16x16x32_bf16(Bt[n][k], At[m][k], acc[ai][bj][m][n], 0, 0, 0); __builtin_amdgcn_s_setprio(0); } while (0)
#define PG8_WAIT_V(n) asm volatile("s_waitcnt vmcnt(" #n ")" ::: "memory")
#define PG8_WAIT_L(n) asm volatile("s_waitcnt lgkmcnt(" #n ")" ::: "memory")
#define PG8_BAR __builtin_amdgcn_s_barrier()
#define PG8_SCHED __builtin_amdgcn_sched_barrier(0)
    Unit cur, nxt; int ui = 0;
    if (!S.next(0, cur)) return;
    f32x4 acc[2][2][4][2];
#pragma unroll
    for (int a = 0; a < 2; ++a)
#pragma unroll
        for (int b = 0; b < 2; ++b)
#pragma unroll
            for (int m = 0; m < 4; ++m)
#pragma unroll
                for (int n = 0; n < 2; ++n) acc[a][b][m][n] = (f32x4){0.f, 0.f, 0.f, 0.f};
    bf16x8 At[4][2], B0[2][2], B1[2][2];
    const char* cA = (const char*)g.A + (size_t)cur.pm * tstepA + (size_t)cur.koff * 2; const char* cB = (const char*)g.Bt + (size_t)cur.pn * tstepB + (size_t)cur.koff * 2;
    PG8_STAGE(PG8_SB(0, 0), cB, voffB); PG8_STAGE(PG8_SB(0, 1), cB + hstepB, voffB); PG8_STAGE(PG8_SA(0, 0), cA, voffA); PG8_STAGE(PG8_SA(0, 1), cA + hstepA, voffA);
    if (wr == 1) PG8_BAR;
    PG8_WAIT_V(2); PG8_BAR;
    PG8_STAGE(PG8_SB(1, 0), cB + kstep, voffB); PG8_STAGE(PG8_SA(1, 0), cA + kstep, voffA); PG8_STAGE(PG8_SB(1, 1), cB + hstepB + kstep, voffB);
    PG8_WAIT_V(6); PG8_BAR;
    for (;;) {
        const bool has_next = S.next(ui + 1, nxt);
        const char* nA = has_next ? (const char*)g.A + (size_t)nxt.pm * tstepA + (size_t)nxt.koff * 2 : cA; const char* nB = has_next ? (const char*)g.Bt + (size_t)nxt.pn * tstepB + (size_t)nxt.koff * 2 : cB;
        const int nt = cur.nt;
        for (int t = 0; t < nt; t += 2) {
            const bool last = (t == nt - 2);
            const char* a1 = cA + (size_t)(t + 1) * kstep;
            const char* a2 = last ? nA : cA + (size_t)(t + 2) * kstep; const char* b2 = last ? nB : cB + (size_t)(t + 2) * kstep;
            const char* a3 = a2 + kstep; const char* b3 = b2 + kstep;
            PG8_LDB(B0, 0, 0); PG8_LDB(B1, 0, 1); PG8_SCHED; PG8_LDA(At, 0, 0); PG8_STAGE(PG8_SA(1, 1), a1 + hstepA, voffA);
            PG8_WAIT_V(8); PG8_WAIT_L(0); PG8_BAR; PG8_MMA(0, 0, At, B0); PG8_MMA(0, 1, At, B1); PG8_BAR; PG8_SCHED;
            PG8_LDA(At, 0, 1); PG8_STAGE(PG8_SB(0, 0), b2, voffB); PG8_STAGE(PG8_SB(0, 1), b2 + hstepB, voffB); PG8_STAGE(PG8_SA(0, 0), a2, voffA);
            PG8_WAIT_V(8); PG8_WAIT_L(0); PG8_BAR; PG8_MMA(1, 0, At, B0); PG8_MMA(1, 1, At, B1); PG8_BAR; PG8_SCHED;
            PG8_LDB(B0, 1, 0); PG8_LDB(B1, 1, 1); PG8_SCHED; PG8_LDA(At, 1, 0); PG8_STAGE(PG8_SA(0, 1), a2 + hstepA, voffA);
            PG8_WAIT_V(8); PG8_WAIT_L(0); PG8_BAR; PG8_MMA(0, 0, At, B0); PG8_MMA(0, 1, At, B1); PG8_BAR; PG8_SCHED;
            PG8_LDA(At, 1, 1); PG8_STAGE(PG8_SB(1, 0), b3, voffB); PG8_STAGE(PG8_SB(1, 1), b3 + hstepB, voffB); PG8_STAGE(PG8_SA(1, 0), a3, voffA);
            PG8_WAIT_V(8); PG8_WAIT_L(0); PG8_BAR; PG8_MMA(1, 0, At, B0); PG8_MMA(1, 1, At, B1); PG8_BAR; PG8_SCHED;
        }
        if constexpr (ALIGN_EPI) { if (wr == 0) PG8_BAR; }
        E(acc, cur, wr, wc, fr, fq);
        if (!has_next) break;
#pragma unroll
        for (int a = 0; a < 2; ++a)
#pragma unroll
            for (int b = 0; b < 2; ++b)
#pragma unroll
                for (int m = 0; m < 4; ++m)
#pragma unroll
                    for (int n = 0; n < 2; ++n) acc[a][b][m][n] = (f32x4){0.f, 0.f, 0.f, 0.f};
        cur = nxt; cA = nA; cB = nB; ++ui;
        { int l2; asm volatile("v_mbcnt_lo_u32_b32 %0, -1, 0\n\tv_mbcnt_hi_u32_b32 %0, -1, %0" : "=v"(l2)); const int t2 = wid * 64 + l2; PG8_VOFFS(t2); const int fr2 = l2 & 15, fq2 = l2 >> 4; aoff = lds_byte(wr * 64 + fr2, fq2 * 8); boff = lds_byte(wc * 32 + fr2, fq2 * 8); }
        if constexpr (ALIGN_EPI) { if (wr == 1) PG8_BAR; }
    }
    PG8_WAIT_V(0);
    if constexpr (!ALIGN_EPI) { if (wr == 0) PG8_BAR; }
    PG8_BAR;
#undef PG8_SA
#undef PG8_SB
#undef PG8_STAGE
#undef PG8_LDA
#undef PG8_LDB
#undef PG8_MMA
#undef PG8_WAIT_V
#undef PG8_WAIT_L
#undef PG8_BAR
#undef PG8_SCHED
#undef PG8_VOFFS
}
}


#define XB_TMO      128
#define XB_XCNT(j)  (256  + 64 * (j))
#define XB_XSUB(j)  (1280 + 64 * (j))
#define XB_XGEN(j)  (2304 + 64 * (j))
#define XB_TOP      3328
#define XB_TOPGEN   3392
#define XCD_BAR_WORDS 3456
#define XB_SPIN_CAP (1u << 22)
__device__ __forceinline__ unsigned xb_ld(unsigned* p)              { return __hip_atomic_load(p, __ATOMIC_RELAXED, __HIP_MEMORY_SCOPE_AGENT); }
__device__ __forceinline__ unsigned xb_add(unsigned* p, unsigned v) { return __hip_atomic_fetch_add(p, v, __ATOMIC_RELAXED, __HIP_MEMORY_SCOPE_AGENT); }
__device__ __forceinline__ unsigned xb_xcc_id() { return (unsigned)__builtin_amdgcn_s_getreg((3 << 11) | 20) & 0xFu; }
#define XB_SPIN(cond, bar) do { unsigned _sp = 0; while (cond) { __builtin_amdgcn_s_sleep(1); \
    if ((++_sp & 255u) == 0u) { if (xb_ld(&(bar)[XB_TMO])) break; if (_sp > XB_SPIN_CAP) { atomicAdd(&(bar)[XB_TMO], 1u); break; } } } } while (0)
struct XcdBarrier { unsigned* bar; unsigned x; volatile LAS unsigned* st; };
__device__ __forceinline__ void xcd_barrier_complete(unsigned* bar, unsigned x, unsigned& nloc, unsigned& nx) {
    const unsigned G = gridDim.x * gridDim.y * gridDim.z;
    unsigned sum, cnt, mine, sp = 0u;
    for (;;) {
        sum = 0u; cnt = 0u; mine = 0u;
#pragma unroll
        for (unsigned j = 0; j < 16; ++j) { const unsigned c = xb_ld(&bar[XB_XCNT(j)]); sum += c; cnt += (c > 0u) ? 1u : 0u; mine = (j == x) ? c : mine; }
        if (sum == G) break;
        __builtin_amdgcn_s_sleep(1);
        if ((++sp & 255u) == 0u) { if (xb_ld(&bar[XB_TMO])) break; if (sp > XB_SPIN_CAP) { atomicAdd(&bar[XB_TMO], 1u); break; } }
    }
    nloc = mine > 0u ? mine : 1u; nx = cnt > 0u ? cnt : 1u;
}
__device__ __forceinline__ void xcd_barrier(const XcdBarrier& b, bool t0) {
    asm volatile("s_waitcnt vmcnt(0)" ::: "memory");
    __syncthreads();
    if (t0) {
        unsigned* bar = b.bar;
        __builtin_amdgcn_s_waitcnt(0);
        unsigned nloc = b.st[0], nx = b.st[1];
        if (nloc == 0u) { xcd_barrier_complete(bar, b.x, nloc, nx); b.st[0] = nloc; b.st[1] = nx; }
        const unsigned old = xb_add(&bar[XB_XSUB(b.x)], 1u);
        const unsigned gen = old / nloc;
        if (old + 1u == (gen + 1u) * nloc) {
            __builtin_amdgcn_fence(__ATOMIC_RELEASE, "agent");
            asm volatile("s_waitcnt vmcnt(0)" ::: "memory");
            const unsigned og = xb_add(&bar[XB_TOP], 1u);
            const unsigned tg = og / nx;
            if (og + 1u == (tg + 1u) * nx) xb_add(&bar[XB_TOPGEN], 1u);
            else XB_SPIN(xb_ld(&bar[XB_TOPGEN]) == tg, bar);
            __builtin_amdgcn_fence(__ATOMIC_ACQUIRE, "agent");
            xb_add(&bar[XB_XGEN(b.x)], 1u);
            asm volatile("s_waitcnt vmcnt(0)" ::: "memory");
        } else {
            XB_SPIN(xb_ld(&bar[XB_XGEN(b.x)]) == gen, bar);
            __builtin_amdgcn_fence(__ATOMIC_ACQUIRE, "agent");
            asm volatile("s_waitcnt vmcnt(0)" ::: "memory");
        }
    }
    __syncthreads();
}

struct Args { const float* in[24]; float* out; unsigned char* ws; };
enum { I_X = 0, I_C, I_CTX, I_CCTX, I_WMOD, I_BMOD, I_WIN, I_WOUT, I_CDW, I_CB, I_CLG, I_CLB, I_CPW, I_MQG, I_MKVG, I_MUQ, I_MUKV, I_GQG, I_GKG, I_RDEC, I_RNG, I_W1, I_W2, I_FG };

__device__ __forceinline__ void transpose_item(const float* W, int K, int N, bf16_t* WT, LAS float* scr, int item, int lane) {
    const int nblk = N / 32, kb = item / nblk, nb = item % nblk, k0 = 64 * kb, n0 = 32 * nb;
#pragma unroll 8
    for (int i = 0; i < 32; ++i) { const int kk = 2 * i + (lane >> 5); scr[kk * 33 + (lane & 31)] = W[(size_t)(k0 + kk) * N + n0 + (lane & 31)]; }
    asm volatile("s_waitcnt lgkmcnt(0)" ::: "memory");
    const int c = lane & 7;
#pragma unroll
    for (int j = 0; j < 4; ++j) { const int n = (lane >> 3) + 8 * j; const LAS float* s = scr + (8 * c) * 33 + n;
        u32x4 o; o.x = cvt_pk_bf16(s[0 * 33], s[1 * 33]); o.y = cvt_pk_bf16(s[2 * 33], s[3 * 33]); o.z = cvt_pk_bf16(s[4 * 33], s[5 * 33]); o.w = cvt_pk_bf16(s[6 * 33], s[7 * 33]);
        *(u32x4*)(WT + (size_t)(n0 + n) * K + k0 + 8 * c) = o; }
    asm volatile("s_waitcnt lgkmcnt(0)" ::: "memory");
}

__device__ __forceinline__ void norm_row_mod(const float* xrow, const float* sh, const float* sc, bf16_t* orow, int lane) {
    const f32x4* xr = (const f32x4*)xrow + lane;
    f32x4 v[4], av[4], bv[4]; float s = 0.f;
#pragma unroll
    for (int j = 0; j < 4; ++j) { v[j] = xr[64 * j]; av[j] = ((const f32x4*)sh)[lane + 64 * j]; bv[j] = ((const f32x4*)sc)[lane + 64 * j]; }
#pragma unroll
    for (int j = 0; j < 4; ++j) s += (v[j].x * v[j].x + v[j].y * v[j].y) + (v[j].z * v[j].z + v[j].w * v[j].w);
    const float rstd = rsqrtf(wave_sum(s, lane) * (1.f / DM) + EPS);
    u32x2* o8 = (u32x2*)orow + lane;
#pragma unroll
    for (int j = 0; j < 4; ++j) { const f32x4 a = av[j], b = bv[j];
        const f32x4 y = v[j] * rstd * (b + 1.0f) + a;
        u32x2 w; w.x = cvt_pk_bf16(y.x, y.y); w.y = cvt_pk_bf16(y.z, y.w); o8[64 * j] = w; }
}

typedef short v4i16_t __attribute__((ext_vector_type(4)));
__device__ __forceinline__ v4i16_t vtr(const LAS unsigned char* p) { return __builtin_amdgcn_ds_read_tr16_b64_v4i16((LAS v4i16_t*)p); }
template <int DQ, bool NOMAX>
__device__ __forceinline__ void attn_unit(LAS unsigned char* lds, const bf16_t* Qp, int ldq, const bf16_t* Kp, int ldk, const bf16_t* Kx, const bf16_t* Vp, int ldv,
                                          bf16_t* Op, int qrow0, int qpos0, int nkt, int kseg0_row, int kseg1_row, bool rope, float C_, const int tid) {
    float C = C_; asm volatile("" : "+v"(C));
    constexpr int KST = DQ * 2 + 16, BUFSZ = 64 * KST + 8192, NS = DQ / 16;
    const int lane = tid & 63, wave = __builtin_amdgcn_readfirstlane(tid >> 6), li = lane & 31, hi = lane >> 5;
    f32x16 O0, O1;
#pragma unroll
    for (int r = 0; r < 16; ++r) { O0[r] = 0.f; O1[r] = 0.f; }
    float mrun = -INFINITY, lrun = 0.f;
    const int skey = tid >> 3, sch = tid & 7;
    const int xkey = tid >> 3, xch = tid & 7;
    const int kwoff = skey * KST + sch * 16, xwoff = xkey * KST + 128 + xch * 8;
    const int vwoff = 64 * KST + (skey >> 2) * 512 + (sch >> 2) * 256 + (skey & 3) * 64 + (sch & 3) * 16;
    const int aoff = li * KST + hi * 16;
    const int vroff = 64 * KST + hi * 512 + ((lane & 15) >> 2) * 64 + ((lane >> 4) & 1) * 32 + (lane & 3) * 8;
    u32x4 kregA, vregA, kregB, vregB; u32x2 xregA, xregB;
#define ATT_GLOAD(t, KR, VR, XR) do { const int row_ = ((t) < 4 ? kseg0_row + 64 * (t) : kseg1_row + 64 * ((t) - 4)); \
        KR = *(const u32x4*)(Kp + (size_t)(row_ + skey) * ldk + 8 * sch); \
        VR = *(const u32x4*)(Vp + (size_t)(row_ + skey) * ldv + 8 * sch); \
        if constexpr (DQ == 96) { XR = *(const u32x2*)(Kx + (size_t)(row_ + xkey) * DINP + 4 * xch); } } while (0)
#define ATT_LSTORE(buf, KR, VR, XR) do { LAS unsigned char* B_ = lds + (buf) * BUFSZ; \
        *(LAS u32x4*)(B_ + kwoff) = KR; *(LAS u32x4*)(B_ + vwoff) = VR; \
        if constexpr (DQ == 96) { *(LAS u32x2*)(B_ + xwoff) = XR; } } while (0)
#define ATT_TILE(t, LK, LV, LX, SK, SV, SX) do { \
        if ((t) + 2 < nkt) ATT_GLOAD((t) + 2, LK, LV, LX); \
        const LAS unsigned char* Bb = lds + ((t) & 1) * BUFSZ; \
        bf16x8 kf0[NS], kf1[NS]; \
        _Pragma("unroll") for (int s = 0; s < NS; ++s) { kf0[s] = *(const LAS bf16x8*)(Bb + aoff + s * 32); kf1[s] = *(const LAS bf16x8*)(Bb + 32 * KST + aoff + s * 32); } \
        v4i16_t vl0[4], vh0[4], vl1[4], vh1[4]; \
        if constexpr (DQ == 64) { _Pragma("unroll") for (int ks = 0; ks < 4; ++ks) { const LAS unsigned char* vb = Bb + vroff + ks * 2048; vl0[ks] = vtr(vb); vh0[ks] = vtr(vb + 1024); vl1[ks] = vtr(vb + 256); vh1[ks] = vtr(vb + 1024 + 256); } } \
        __builtin_amdgcn_sched_barrier(0); \
        f32x16 S0, S1; \
        _Pragma("unroll") for (int r = 0; r < 16; ++r) { S0[r] = 0.f; S1[r] = 0.f; } \
        _Pragma("unroll") for (int s = 0; s < NS; ++s) { \
            S0 = __builtin_amdgcn_mfma_f32_32x32x16_bf16(kf0[s], qf[s], S0, 0, 0, 0); \
            S1 = __builtin_amdgcn_mfma_f32_32x32x16_bf16(kf1[s], qf[s], S1, 0, 0, 0); } \
        float ls0 = 0.f, ls1 = 0.f; \
        if constexpr (NOMAX) {     \
            _Pragma("unroll") for (int r = 0; r < 16; ++r) { S0[r] = fexp2(S0[r]); S1[r] = fexp2(S1[r]); ls0 += S0[r]; ls1 += S1[r]; } \
        } else { \
        float mxa = fmaxf(S0[0], S1[0]), mxb = fmaxf(S0[1], S1[1]); \
        _Pragma("unroll") for (int r = 2; r < 16; r += 2) { mxa = fmaxf(fmaxf(mxa, S0[r]), S1[r]); mxb = fmaxf(fmaxf(mxb, S0[r + 1]), S1[r + 1]); }     \
        float mx = fmaxf(mxa, mxb); \
        mx = fmaxf(mx, shx(mx, 32, lane)); \
        if (__builtin_amdgcn_ballot_w64(mx > mrun) != 0ull) { \
            const float mnew = fmaxf(mrun, mx); \
            const float alpha = fexp2((mrun - mnew) * C); \
            mrun = mnew; lrun *= alpha; \
            _Pragma("unroll") for (int r = 0; r < 16; ++r) { O0[r] *= alpha; O1[r] *= alpha; } } \
        const float mc = mrun * C; \
        _Pragma("unroll") for (int r = 0; r < 16; ++r) { S0[r] = fexp2(S0[r] * C - mc); S1[r] = fexp2(S1[r] * C - mc); ls0 += S0[r]; ls1 += S1[r]; } \
        } \
        lrun += ls0 + ls1; \
        if constexpr (DQ != 64) { __builtin_amdgcn_sched_barrier(0); _Pragma("unroll") for (int ks = 0; ks < 4; ++ks) { const LAS unsigned char* vb = Bb + vroff + ks * 2048; vl0[ks] = vtr(vb); vh0[ks] = vtr(vb + 1024); vl1[ks] = vtr(vb + 256); vh1[ks] = vtr(vb + 1024 + 256); } } \
        bf16x8 pb[4]; \
        _Pragma("unroll") for (int e = 0; e < 2; ++e) { u32x4 w0, w1; \
            w0.x = cvt_pk_bf16(S0[8 * e + 0], S0[8 * e + 1]); w0.y = cvt_pk_bf16(S0[8 * e + 2], S0[8 * e + 3]); w0.z = cvt_pk_bf16(S0[8 * e + 4], S0[8 * e + 5]); w0.w = cvt_pk_bf16(S0[8 * e + 6], S0[8 * e + 7]); \
            w1.x = cvt_pk_bf16(S1[8 * e + 0], S1[8 * e + 1]); w1.y = cvt_pk_bf16(S1[8 * e + 2], S1[8 * e + 3]); w1.z = cvt_pk_bf16(S1[8 * e + 4], S1[8 * e + 5]); w1.w = cvt_pk_bf16(S1[8 * e + 6], S1[8 * e + 7]); \
            pb[e] = __builtin_bit_cast(bf16x8, w0); pb[2 + e] = __builtin_bit_cast(bf16x8, w1); } \
        _Pragma("unroll") for (int ks = 0; ks < 4; ++ks) { \
            const bf16x8 a0 = __builtin_shufflevector(vl0[ks], vh0[ks], 0, 1, 2, 3, 4, 5, 6, 7), a1 = __builtin_shufflevector(vl1[ks], vh1[ks], 0, 1, 2, 3, 4, 5, 6, 7); \
            O0 = __builtin_amdgcn_mfma_f32_32x32x16_bf16(a0, pb[ks], O0, 0, 0, 0); \
            O1 = __builtin_amdgcn_mfma_f32_32x32x16_bf16(a1, pb[ks], O1, 0, 0, 0); } \
        if ((t) + 1 < nkt) ATT_LSTORE(((t) + 1) & 1, SK, SV, SX); \
        __syncthreads(); } while (0)
    ATT_GLOAD(0, kregA, vregA, xregA); ATT_GLOAD(1, kregB, vregB, xregB);
    bf16x8 qf[NS];
    {
        const bf16_t* qrow = Qp + (size_t)(qrow0 + wave * 32 + li) * ldq;
#pragma unroll
        for (int s = 0; s < 4; ++s) qf[s] = *(const bf16x8*)(qrow + 16 * s + 8 * hi);
        if constexpr (DQ == 96 && NOMAX) {
#pragma unroll
            for (int s = 0; s < 4; ++s) { const u32x4 a = __builtin_bit_cast(u32x4, qf[s]); u32x4 w;
                w.x = cvt_pk_bf16(bflo(a.x) * C_, bfhi(a.x) * C_); w.y = cvt_pk_bf16(bflo(a.y) * C_, bfhi(a.y) * C_); w.z = cvt_pk_bf16(bflo(a.z) * C_, bfhi(a.z) * C_); w.w = cvt_pk_bf16(bflo(a.w) * C_, bfhi(a.w) * C_);
                qf[s] = __builtin_bit_cast(bf16x8, w); }
        }
        if constexpr (DQ == 96) {
            const int t = qpos0 + wave * 32 + li;
#pragma unroll
            for (int s = 4; s < 6; ++s) {
                const u32x4 a = *(const u32x4*)(qrow + 16 * s), b = *(const u32x4*)(qrow + 16 * s + 8);
                float x1[8] = {bflo(a.x), bfhi(a.x), bflo(a.y), bfhi(a.y), bflo(a.z), bfhi(a.z), bflo(a.w), bfhi(a.w)};
                float x2[8] = {bflo(b.x), bfhi(b.x), bflo(b.y), bfhi(b.y), bflo(b.z), bfhi(b.z), bflo(b.w), bfhi(b.w)};
                float y[8];
                const float pos = (float)(s == 4 ? (t >> 6) : (t & 63));
#pragma unroll
                for (int i = 0; i < 8; ++i) {
                    float cs = 1.f, sn = 0.f;
                    if (rope) { const float rev = pos * fexp2(-(float)i * (LOG2_ROPE / 8.f)) * INV_2PI; cs = __builtin_amdgcn_cosf(rev); sn = __builtin_amdgcn_sinf(rev); }
                    y[i] = hi ? (x1[i] * sn + x2[i] * cs) : (x1[i] * cs - x2[i] * sn);
                    if constexpr (NOMAX) y[i] *= C_;
                }
                u32x4 w; w.x = cvt_pk_bf16(y[0], y[1]); w.y = cvt_pk_bf16(y[2], y[3]); w.z = cvt_pk_bf16(y[4], y[5]); w.w = cvt_pk_bf16(y[6], y[7]);
                qf[s] = __builtin_bit_cast(bf16x8, w);
            }
        }
    }
    ATT_LSTORE(0, kregA, vregA, xregA);
    __syncthreads();
    for (int t = 0; t < nkt; t += 2) {
        ATT_TILE(t, kregA, vregA, xregA, kregB, vregB, xregB);
        ATT_TILE(t + 1, kregB, vregB, xregB, kregA, vregA, xregA);
    }
#undef ATT_TILE
#undef ATT_GLOAD
#undef ATT_LSTORE
    const float ltot = lrun + shx(lrun, 32, lane);
    const float rl = 1.0f / ltot;
    bf16_t* orow = Op + (size_t)(qrow0 + wave * 32 + li) * DM;
#pragma unroll
    for (int rg = 0; rg < 4; ++rg) {
        u32x2 w0, w1;
        w0.x = cvt_pk_bf16(O0[4 * rg] * rl, O0[4 * rg + 1] * rl); w0.y = cvt_pk_bf16(O0[4 * rg + 2] * rl, O0[4 * rg + 3] * rl);
        w1.x = cvt_pk_bf16(O1[4 * rg] * rl, O1[4 * rg + 1] * rl); w1.y = cvt_pk_bf16(O1[4 * rg + 2] * rl, O1[4 * rg + 3] * rl);
        *(u32x2*)(orow + 8 * rg + 4 * hi) = w0;
        *(u32x2*)(orow + 32 + 8 * rg + 4 * hi) = w1;
    }
}

__global__ void __launch_bounds__(512, 2) mega_fwd(Args a) {
    extern __shared__ __attribute__((aligned(16))) unsigned char lds_raw[];
    LAS unsigned char* lds = (LAS unsigned char*)lds_raw;
    cg::grid_group grid = cg::this_grid();
    const int G = gridDim.x; int bid = blockIdx.x;
    const int NGW = G * 8;
    const int wave0 = __builtin_amdgcn_readfirstlane((int)threadIdx.x >> 6);
    volatile LAS unsigned* bst = (volatile LAS unsigned*)(lds + 131072 + 64);
    if (threadIdx.x < 4) bst[threadIdx.x] = 0u;
    __syncthreads();
    XcdBarrier xbar; xbar.bar = (unsigned*)(a.ws + WS_CTL); xbar.x = xb_xcc_id(); xbar.st = bst;
    if (blockIdx.x == 0) { for (int i = threadIdx.x; i < (int)(CTL_BYTES / 4); i += 512) __hip_atomic_store(xbar.bar + i, 0u, __ATOMIC_RELAXED, __HIP_MEMORY_SCOPE_AGENT); }
    const bool thr0 = (threadIdx.x == 0);
#define GRID_BAR() xcd_barrier(xbar, thr0)
#define PHASE_IDS() int lane_; asm volatile("v_mbcnt_lo_u32_b32 %0, -1, 0\n\tv_mbcnt_hi_u32_b32 %0, -1, %0" : "=v"(lane_)); const int lane = lane_; const int wave = wave0; const int tid = wave * 64 + lane; const int gw = bid * 8 + wave; (void)lane; (void)gw; (void)tid; \
    const AS4 char* kp_ = (const AS4 char*)__builtin_amdgcn_kernarg_segment_ptr(); asm volatile("" : "+s"(kp_)); unsigned char* const ws = *(unsigned char* const AS4*)(kp_ + 200); (void)ws;
#define AS4 __attribute__((address_space(4)))
#define IN(i) (*(const float* const AS4*)(kp_ + 8 * (i)))
#define OUTP (*(float* const AS4*)(kp_ + 192))
#define MOD ((float*)(ws + WS_MOD))
#define WINT ((bf16_t*)(ws + WS_WIN))
#define WOUTT ((bf16_t*)(ws + WS_WOUT))
#define W1T ((bf16_t*)(ws + WS_W1))
#define W2T ((bf16_t*)(ws + WS_W2))
#define UQT ((bf16_t*)(ws + WS_UQ))
#define UKVT ((bf16_t*)(ws + WS_UKV))
#define PWT ((bf16_t*)(ws + WS_PW))
#define CX ((float*)(ws + WS_CX))
#define CKV ((float*)(ws + WS_CKV))
#define SPT ((bf16_t*)(ws + WS_SPT))
#define XN ((bf16_t*)(ws + WS_XN))
#define CA ((bf16_t*)(ws + WS_XN))
#define U ((bf16_t*)(ws + WS_U))
#define YCAT ((bf16_t*)(ws + WS_YCAT))
#define QM ((bf16_t*)(ws + WS_QM))
#define KVM ((bf16_t*)(ws + WS_KVM))
#define HB ((bf16_t*)(ws + WS_H))
#define modl (MOD + (size_t)l * 9 * NMOD)
#define xlat_in ((l == 0) ? IN(I_X) : OUTP)
#define xctx_in ((l == 0) ? IN(I_CTX) : CX)

    {
        PHASE_IDS();
        LAS float* sc = (LAS float*)lds;
        LAS float* red = sc + 9 * 1024;
        for (int i = tid; i < 9 * 1024; i += 512) { const float v = (i < 8192) ? IN(I_C)[i] : IN(I_CCTX)[i - 8192]; sc[i] = v * sigmoidf_(v); }
        if (bid == 0 && tid < DEPTH * 8) { const float dd = IN(I_RDEC)[tid]; MOD[DEPTH * 9 * NMOD + tid] = -log1pf(__expf(-dd)) * LOG2E; }
        __syncthreads();
        for (int item = bid; item < DEPTH * 48; item += G) {
            const int l = item / 48, n0 = (item % 48) * 128;
            const float* W = IN(I_WMOD) + (size_t)l * DM * NMOD + n0 + lane * 2;
            float acc[9][2];
#pragma unroll
            for (int j = 0; j < 9; ++j) { acc[j][0] = 0.f; acc[j][1] = 0.f; }
            for (int kk = 0; kk < 128; ++kk) {
                const int k = wave * 128 + kk; const f32x2 w = *(const f32x2*)(W + (size_t)k * NMOD);
#pragma unroll
                for (int j = 0; j < 9; ++j) { const float s = sc[j * 1024 + k]; acc[j][0] += s * w.x; acc[j][1] += s * w.y; }
            }
#pragma unroll
            for (int j = 0; j < 9; ++j) { red[(wave * 18 + j * 2) * 64 + lane] = acc[j][0]; red[(wave * 18 + j * 2 + 1) * 64 + lane] = acc[j][1]; }
            __syncthreads();
            for (int o = tid; o < 18 * 64; o += 512) {
                const int aidx = o >> 6, ln = o & 63; float s = 0.f;
#pragma unroll
                for (int w = 0; w < 8; ++w) s += red[(w * 18 + aidx) * 64 + ln];
                const int j = aidx >> 1, n = n0 + ln * 2 + (aidx & 1);
                MOD[((size_t)l * 9 + j) * NMOD + n] = s + IN(I_BMOD)[(size_t)l * NMOD + n];
            }
            __syncthreads();
        }
    }
    grid.sync();
    if (threadIdx.x == 0) { const unsigned jl = xb_add(&xbar.bar[XB_XCNT(xbar.x)], 1u); bst[2] = jl; }

    for (int l = 0; l < DEPTH; ++l) {
        const bool last = (l == DEPTH - 1);
        const int Mrows = last ? TL : TT;

        {
            PHASE_IDS();
            LAS float* scr = (LAS float*)(lds + wave * 16384);
            constexpr int IT_IN = 16 * 77, IT_OUT = 16 * 32, IT_W1 = 16 * 128, IT_W2 = 64 * 32, IT_UQ = 4 * 12, IT_UKV = 2 * 16, IT_PW = 4 * 8;
            constexpr int NIT = IT_IN + IT_OUT + IT_W1 + IT_W2 + IT_UQ + IT_UKV + IT_PW;
            for (int it = gw; it < NIT; it += NGW) {
                int r = it;
                if (r < IT_IN) { transpose_item(IN(I_WIN) + (size_t)l * DM * DIN, DM, DIN, WINT, scr, r, lane); continue; } r -= IT_IN;
                if (r < IT_OUT) { transpose_item(IN(I_WOUT) + (size_t)l * DM * DM, DM, DM, WOUTT, scr, r, lane); continue; } r -= IT_OUT;
                if (r < IT_W1) { transpose_item(IN(I_W1) + (size_t)l * DM * DFF, DM, DFF, W1T, scr, r, lane); continue; } r -= IT_W1;
                if (r < IT_W2) { transpose_item(IN(I_W2) + (size_t)l * DFF * DM, DFF, DM, W2T, scr, r, lane); continue; } r -= IT_W2;
                if (r < IT_UQ) { transpose_item(IN(I_MUQ) + (size_t)l * 256 * 384, 256, 384, UQT, scr, r, lane); continue; } r -= IT_UQ;
                if (r < IT_UKV) { transpose_item(IN(I_MUKV) + (size_t)l * 128 * 512, 128, 512, UKVT, scr, r, lane); continue; } r -= IT_UKV;
                transpose_item(IN(I_CPW) + (size_t)l * 256 * 256, 256, 256, PWT, scr, r, lane);
            }
            if (bid == 0 && tid < 168) ((unsigned*)(ws + WS_NB))[tid] = 0u;
            {
                const int gt = bid * 512 + tid, ngt = G * 512; unsigned zz = 0u; asm volatile("" : "+v"(zz)); const u32x4 z = {zz, zz, zz, zz};
                u32x4* p0 = (u32x4*)(WINT + (size_t)DIN * DM);
                for (int i = gt; i < (DINP - DIN) * DM / 8; i += ngt) p0[i] = z;
                u32x4* p1 = (u32x4*)(UQT + (size_t)384 * 256);
                for (int i = gt; i < 128 * 256 / 8; i += ngt) p1[i] = z;
            }
            for (int m = gw; m < TT; m += NGW) {
                const bool isl = m < TL; const int j = isl ? (m >> 12) : 8;
                if (!isl && l > 0) {
                    f32x4* cr = (f32x4*)(CX + (size_t)(m - TL) * DM) + lane;
                    const f32x4* pr = (const f32x4*)((const float*)(ws + WS_KVM) + (size_t)(m - TL) * DM) + lane;
                    const f32x4* gp = (const f32x4*)(MOD + (size_t)(l - 1) * 9 * NMOD + (size_t)8 * NMOD + 5 * DM) + lane;
#pragma unroll
                    for (int jj = 0; jj < 4; ++jj) {
                        const f32x4 p = (pr[64 * jj] + pr[64 * jj + (size_t)TC * DM / 4]) + (pr[64 * jj + 2 * (size_t)TC * DM / 4] + pr[64 * jj + 3 * (size_t)TC * DM / 4]);
                        cr[64 * jj] = cr[64 * jj] + gp[64 * jj] * p;
                    }
                    asm volatile("s_waitcnt vmcnt(0)" ::: "memory");
                }
                const float* xr = isl ? xlat_in + (size_t)m * DM : xctx_in + (size_t)(m - TL) * DM;
                norm_row_mod(xr, modl + (size_t)j * NMOD + 0 * DM, modl + (size_t)j * NMOD + 1 * DM, XN + (size_t)m * DM, lane);
            }
        }
        GRID_BAR();

        if (l == 0) {
            if (threadIdx.x == 0) {
                bool ok = (G == 256);
#pragma unroll
                for (unsigned jx = 0; jx < 16; ++jx) { const unsigned cnt = xb_ld(&xbar.bar[XB_XCNT(jx)]); ok = ok && (cnt == (jx < 8 ? 32u : 0u)); }
                bst[3] = ok ? (bst[2] * 8u + xbar.x) : (unsigned)blockIdx.x;
            }
            __syncthreads();
            bid = __builtin_amdgcn_readfirstlane((int)bst[3]);
        }

        {
            PHASE_IDS();
            pg8::Gemm g{XN, WINT, TT, DINP, DM, DM}; pg8::StaticOrder S; S.init(TT, DINP, G, bid, g.K);
            pg8::EpiBf16<0> E{U, DINP};
            for (int rep = 0; rep < PROBE_GEMM; ++rep)
            pg8::gemm_phase<pg8::EpiBf16<0>, pg8::StaticOrder>(lds, g, S, E, tid);
        }
        GRID_BAR();

        {
            PHASE_IDS();
            LAS float* glu = (LAS float*)lds;
            LAS float* dwl = glu + 94 * 256;
            const float* dw = IN(I_CDW) + (size_t)l * 31 * 256;
            for (int i = tid; i < 31 * 256; i += 512) dwl[i] = dw[i];
            const f32x4 cb4 = *(const f32x4*)(IN(I_CB) + l * 256 + 4 * lane), lg4 = *(const f32x4*)(IN(I_CLG) + l * 256 + 4 * lane), lb4 = *(const f32x4*)(IN(I_CLB) + l * 256 + 4 * lane);
            const f32x4 gq4 = *(const f32x4*)(IN(I_MQG) + l * 256 + 4 * lane);
            const f32x2 gkv2 = *(const f32x2*)(IN(I_MKVG) + l * 128 + 2 * lane);
            const int i16 = lane & 15;
            float gg_q[4], gg_k[4];
#pragma unroll
            for (int e = 0; e < 4; ++e) { gg_q[e] = IN(I_GQG)[l * 64 + 16 * e + i16]; gg_k[e] = IN(I_GKG)[l * 64 + 16 * e + i16]; }
            const float fr16 = fexp2(-(float)i16 * (LOG2_ROPE / 16.f)) * INV_2PI;
            const float fr8 = fexp2(-(float)(lane & 7) * (LOG2_ROPE / 8.f)) * INV_2PI;
            for (int tile = bid; tile < TT / 64; tile += G) {
                const int r0 = tile * 64;
                const int seq_lo = (r0 < TL) ? (r0 & ~4095) : (TL + ((r0 - TL) & ~255));
                const int seq_hi = (r0 < TL) ? seq_lo + 4096 : seq_lo + 256;
                u32x2 pva[12], pvg[12];
#pragma unroll
                for (int q = 0; q < 12; ++q) { const int it = tid + 512 * q; const int rr = it >> 6, c4 = (it & 63) * 4; const int row = r0 - 15 + rr;
                    pva[q] = (u32x2){0u, 0u}; pvg[q] = (u32x2){0u, 0u};
                    if (it < 94 * 64 && row >= seq_lo && row < seq_hi) { pva[q] = *(const u32x2*)(U + (size_t)row * DINP + C_A + c4); pvg[q] = *(const u32x2*)(U + (size_t)row * DINP + C_A + 256 + c4); } }
                __syncthreads();
#pragma unroll
                for (int q = 0; q < 12; ++q) { const int it = tid + 512 * q; const int rr = it >> 6, c4 = (it & 63) * 4;
                    if (it < 94 * 64) { const u32x2 va = pva[q], vg = pvg[q]; f32x4 gv;
                        gv.x = bflo(va.x) * sigmoidf_(bflo(vg.x)); gv.y = bfhi(va.x) * sigmoidf_(bfhi(vg.x)); gv.z = bflo(va.y) * sigmoidf_(bflo(vg.y)); gv.w = bfhi(va.y) * sigmoidf_(bfhi(vg.y));
                        *(LAS f32x4*)(glu + rr * 256 + c4) = gv; } }
                __syncthreads();
#pragma unroll 1
                for (int tg = 0; tg < 2; ++tg) {
                    const int tl0 = wave * 8 + tg * 4;
                    f32x4 acc4[4] = {cb4, cb4, cb4, cb4};
                    f32x4 dwin[4];
#pragma unroll
                    for (int k = 0; k < 4; ++k) dwin[k] = (f32x4){0.f, 0.f, 0.f, 0.f};
#pragma unroll
                    for (int r = 0; r < 34; ++r) {
                        const f32x4 gx = *(const LAS f32x4*)(glu + (tl0 + r) * 256 + 4 * lane);
#pragma unroll
                        for (int k = 3; k > 0; --k) dwin[k] = dwin[k - 1];
                        dwin[0] = (r < 31) ? *(const LAS f32x4*)(dwl + r * 256 + 4 * lane) : (f32x4){0.f, 0.f, 0.f, 0.f};
#pragma unroll
                        for (int k = 0; k < 4; ++k) if (r - k >= 0 && r - k < 31) acc4[k] += gx * dwin[k];
                    }
#pragma unroll
                    for (int k = 0; k < 4; ++k) {
                        const int row = r0 + tl0 + k; const f32x4 acc = acc4[k];
                        const float mean = wave_sum((acc.x + acc.y) + (acc.z + acc.w), lane) * (1.f / 256.f);
                        const f32x4 d = acc - mean;
                        const float var = wave_sum((d.x * d.x + d.y * d.y) + (d.z * d.z + d.w * d.w), lane) * (1.f / 256.f);
                        f32x4 y = d * rsqrtf(var + EPS) * lg4 + lb4;
                        y.x *= sigmoidf_(y.x); y.y *= sigmoidf_(y.y); y.z *= sigmoidf_(y.z); y.w *= sigmoidf_(y.w);
                        u32x2 w2; w2.x = cvt_pk_bf16(y.x, y.y); w2.y = cvt_pk_bf16(y.z, y.w);
                        *(u32x2*)(CA + (size_t)row * 256 + 4 * lane) = w2;
                    }
                }
                float kpe2 = 0.f;
#pragma unroll 4
                for (int tk = 0; tk < 8; ++tk) {
                    const int tl = wave * 8 + tk; const int row = r0 + tl;
                    bf16_t* ur = U + (size_t)row * DINP;
                    const bool isl = row < TL; const int tpos = row & 4095;
                    const float prow = (float)(tpos >> 6), pcol = (float)(tpos & 63);
                    {
                        const u32x2 v = *(const u32x2*)(ur + C_CQ + 4 * lane);
                        f32x4 x = {bflo(v.x), bfhi(v.x), bflo(v.y), bfhi(v.y)};
                        const float rs = rsqrtf(wave_sum((x.x * x.x + x.y * x.y) + (x.z * x.z + x.w * x.w), lane) * (1.f / 256.f) + EPS);
                        x = x * rs * gq4;
                        u32x2 w2; w2.x = cvt_pk_bf16(x.x, x.y); w2.y = cvt_pk_bf16(x.z, x.w);
                        *(u32x2*)(ur + C_CQ + 4 * lane) = w2;
                    }
                    {
                        const unsigned v = *(const unsigned*)(ur + C_CKV + 2 * lane);
                        float x0 = bflo(v), x1 = bfhi(v);
                        const float rs = rsqrtf(wave_sum(x0 * x0 + x1 * x1, lane) * (1.f / 128.f) + EPS);
                        *(unsigned*)(ur + C_CKV + 2 * lane) = cvt_pk_bf16(x0 * rs * gkv2.x, x1 * rs * gkv2.y);
                    }
                    {
                        const int blk = (lane >> 3) & 1, i = lane & 7;
                        bf16_t* p = ur + C_KPE + 16 * blk + i;
                        const float x1 = bf1(p[0]), x2 = bf1(p[8]);
                        kpe2 = fmaxf(kpe2, (lane < 16) ? (x1 * x1 + x2 * x2) : 0.f);
                        if (isl && lane < 16) {
                            const float rev = (blk ? pcol : prow) * fr8;
                            const float cs = __builtin_amdgcn_cosf(rev), sn = __builtin_amdgcn_sinf(rev);
                            p[0] = f2bf(x1 * cs - x2 * sn); p[8] = f2bf(x1 * sn + x2 * cs);
                        }
                    }
#pragma unroll
                    for (int pass = 0; pass < 2; ++pass) {
                        const int hd = lane >> 4;
                        const bool act = (pass == 0) || (lane < 32);
                        bf16_t* p = ur + (pass == 0 ? C_GQ : C_GK) + (act ? hd : 0) * 64 + i16;
                        float x0 = bf1(p[0]), x1 = bf1(p[16]), x2 = bf1(p[32]), x3 = bf1(p[48]);
                        const float rs = rsqrtf(sum16((x0 * x0 + x1 * x1) + (x2 * x2 + x3 * x3), lane) * (1.f / 64.f) + EPS);
                        if (pass == 0) { const float rq = rs * (0.125f * LOG2E); x0 *= rq * gg_q[0]; x1 *= rq * gg_q[1]; x2 *= rq * gg_q[2]; x3 *= rq * gg_q[3]; }
                        else { x0 *= rs * gg_k[0]; x1 *= rs * gg_k[1]; x2 *= rs * gg_k[2]; x3 *= rs * gg_k[3]; }
                        if (isl) {
                            const float rr = prow * fr16, rc = pcol * fr16;
                            const float c0 = __builtin_amdgcn_cosf(rr), s0 = __builtin_amdgcn_sinf(rr), c1 = __builtin_amdgcn_cosf(rc), s1 = __builtin_amdgcn_sinf(rc);
                            const float y0 = x0 * c0 - x1 * s0, y1 = x0 * s0 + x1 * c0, y2 = x2 * c1 - x3 * s1, y3 = x2 * s1 + x3 * c1;
                            x0 = y0; x1 = y1; x2 = y2; x3 = y3;
                        }
                        if (act) { p[0] = f2bf(x0); p[16] = f2bf(x1); p[32] = f2bf(x2); p[48] = f2bf(x3); }
                    }
                }
                { const float k2 = wave_sum(kpe2, lane) * 1.02f; const int bb = (r0 < TL) ? (r0 >> 12) : ((r0 - TL) >> 8);
                  if (lane == 0) atomicMax((unsigned*)(ws + WS_NB) + 160 + bb, __float_as_uint(k2)); }
            }
            __syncthreads();
            {
                LAS unsigned char* KF = lds;
                LAS unsigned char* KB = lds + 8192;
                LAS unsigned char* VS = lds + 16384;
                const int li = lane & 31, hi = lane >> 5;
                for (int u = (bid + 192) % G; u < NB * 4 * 34; u += G) {
                    const int b = u / 136, h = (u / 34) & 3, c = u % 34;
                    const int rowbase = (c < 2) ? TL + b * 256 + c * 128 : b * 4096 + (c - 2) * 128;
                    const float lgf2 = MOD[DEPTH * 9 * NMOD + l * 8 + h], lgb2 = MOD[DEPTH * 9 * NMOD + l * 8 + 4 + h];
                    const float kscale = 0.17677669529663687f;
                    __syncthreads();
                    {
                        const int j = tid >> 2, part = tid & 3;
                        const u32x4 kv = *(const u32x4*)(U + (size_t)(rowbase + j) * DINP + C_RK + h * 32 + part * 8);
                        const float wf = fexp2(lgf2 * (float)(127 - j)) * kscale, wb = fexp2(lgb2 * (float)j) * kscale;
                        u32x4 f, g;
                        f.x = cvt_pk_bf16(bflo(kv.x) * wf, bfhi(kv.x) * wf); f.y = cvt_pk_bf16(bflo(kv.y) * wf, bfhi(kv.y) * wf); f.z = cvt_pk_bf16(bflo(kv.z) * wf, bfhi(kv.z) * wf); f.w = cvt_pk_bf16(bflo(kv.w) * wf, bfhi(kv.w) * wf);
                        g.x = cvt_pk_bf16(bflo(kv.x) * wb, bfhi(kv.x) * wb); g.y = cvt_pk_bf16(bflo(kv.y) * wb, bfhi(kv.y) * wb); g.z = cvt_pk_bf16(bflo(kv.z) * wb, bfhi(kv.z) * wb); g.w = cvt_pk_bf16(bflo(kv.w) * wb, bfhi(kv.w) * wb);
                        *(LAS u32x4*)(KF + j * 64 + part * 16) = f; *(LAS u32x4*)(KB + j * 64 + part * 16) = g;
#pragma unroll
                        for (int e = 0; e < 2; ++e) { const int cch = part * 2 + e;
                            const u32x4 vv = *(const u32x4*)(U + (size_t)(rowbase + j) * DINP + C_RV + h * 64 + 8 * cch);
                            *(LAS u32x4*)(VS + (j >> 2) * 512 + (cch >> 2) * 256 + (j & 3) * 64 + (cch & 3) * 16) = vv; }
                    }
                    __syncthreads();
                    if (wave < 4) {
                        const int dir = wave >> 1, dt = wave & 1;
                        const LAS unsigned char* Kd = dir ? KB : KF;
                        const int tro = ((lane & 15) >> 2) * 64 + ((lane >> 4) & 1) * 32 + (lane & 3) * 8;
                        f32x16 D;
#pragma unroll
                        for (int r = 0; r < 16; ++r) D[r] = 0.f;
#pragma unroll
                        for (int st = 0; st < 8; ++st) {
                            const int j0 = 16 * st + 8 * hi;
                            const v4i16_t a0 = vtr(Kd + j0 * 64 + tro), a1 = vtr(Kd + (j0 + 4) * 64 + tro);
                            const v4i16_t b0 = vtr(VS + (j0 >> 2) * 512 + dt * 256 + tro), b1 = vtr(VS + ((j0 >> 2) + 1) * 512 + dt * 256 + tro);
                            const bf16x8 af = __builtin_shufflevector(a0, a1, 0, 1, 2, 3, 4, 5, 6, 7), bfv = __builtin_shufflevector(b0, b1, 0, 1, 2, 3, 4, 5, 6, 7);
                            D = __builtin_amdgcn_mfma_f32_32x32x16_bf16(af, bfv, D, 0, 0, 0);
                        }
                        float* outp = CKV + ((size_t)u * 2 + dir) * 2048 + 32 * dt + li;
#pragma unroll
                        for (int r = 0; r < 16; ++r) outp[crow(r, hi) * 64] = D[r];
                    }
                }
            }
        }
        GRID_BAR();

        {
            PHASE_IDS();
            {
                const int gt = bid * 512 + tid;
                if (gt < 64 * 2048) {
                    const int chain = gt >> 11, e = gt & 2047, dir = chain & 1, bh = chain >> 1, h = bh & 3;
                    const float g128 = fexp2(MOD[DEPTH * 9 * NMOD + l * 8 + dir * 4 + h] * 128.f);
                    const int dk = e >> 6, d = e & 63;
                    float s = 0.f; float cv[34];
#pragma unroll
                    for (int p = 0; p < 34; ++p) {
                        const int c = (dir == 0) ? p : (p < 2 ? 1 - p : 35 - p);
                        cv[p] = CKV[(((size_t)(bh * 34 + c)) * 2 + dir) * 2048 + e];
                    }
#pragma unroll
                    for (int p = 0; p < 34; ++p) {
                        const int c = (dir == 0) ? p : (p < 2 ? 1 - p : 35 - p);
                        const size_t ud = ((size_t)(bh * 34 + c)) * 2 + dir;
                        SPT[ud * 2048 + d * 32 + dk] = f2bf(s);
                        s = s * g128 + cv[p];
                    }
                }
            }
            {
                pg8::Gemm g{CA, PWT, Mrows, 256, 256, 256}; pg8::StaticOrder S; S.init(Mrows, 256, G, bid, g.K);
                pg8::EpiBf16<0> E{YCAT, DM};
                pg8::gemm_phase<pg8::EpiBf16<0>, pg8::StaticOrder>(lds, g, S, E, tid);
            }
            {
                pg8::Gemm g{U + C_CQ, UQT, Mrows, 512, 256, DINP}; pg8::StaticOrder S; S.init(Mrows, 512, G, (bid + 120) % G, g.K);
                pg8::EpiBf16N<0> E{QM, 512, (unsigned*)(ws + WS_NB)};
                pg8::gemm_phase<pg8::EpiBf16N<0>, pg8::StaticOrder>(lds, g, S, E, tid);
            }
            {
                pg8::Gemm g{U + C_CKV, UKVT, TT, 512, 128, DINP}; pg8::StaticOrder S; S.init(TT, 512, G, (bid + 104) % G, g.K);
                pg8::EpiBf16N<1> E{KVM, 512, (unsigned*)(ws + WS_NB)};
                pg8::gemm_phase<pg8::EpiBf16N<1>, pg8::StaticOrder>(lds, g, S, E, tid);
            }
        }
        GRID_BAR();

        {
            PHASE_IDS();
            const float C_MLA = 0.10206207261596575f * LOG2E;
            const unsigned* nbp = (const unsigned*)(ws + WS_NB);
#define mla_safe(b_, h_) (__builtin_amdgcn_readfirstlane(__float_as_int(sqrtf((__uint_as_float(nbp[((b_) * 4 + (h_)) * 3]) + __uint_as_float(nbp[((b_) * 4 + (h_)) * 3 + 1]) + __uint_as_float(nbp[((b_) * 4 + (h_)) * 3 + 2])) * \
        (__uint_as_float(nbp[96 + ((b_) * 4 + (h_)) * 2]) + __uint_as_float(nbp[96 + ((b_) * 4 + (h_)) * 2 + 1]) + __uint_as_float(nbp[160 + (b_)]))) * C_MLA)) < __float_as_int(60.0f))
            bool gqa_safe;
            { float gq = fabsf(IN(I_GQG)[l * 64 + lane]), gk = fabsf(IN(I_GKG)[l * 64 + lane]);
#pragma unroll
              for (int o = 1; o < 64; o <<= 1) { gq = fmaxf(gq, shx(gq, o, lane)); gk = fmaxf(gk, shx(gk, o, lane)); }
              gqa_safe = __builtin_amdgcn_readfirstlane(__float_as_int(8.0f * gq * gk * LOG2E)) < __float_as_int(60.0f); }
            for (int rep = 0; rep < PROBE_ATT; ++rep) {
                const int xcd = bid & 7, j = bid >> 3;
                const int nm = 2 + ((!last && bid < 32) ? 1 : 0), ng = 2 + ((!last && bid >= 32 && bid < 64) ? 1 : 0);
#pragma unroll 1
                for (int r = 0; r < nm; ++r) {
                    const bool cx = (r == 2);
                    const int stream = xcd * 4 + (r & 1) * 2 + (j >> 4), b = cx ? (bid >> 2) : (stream >> 2), h = cx ? (bid & 3) : (stream & 3), qb = j & 15;
                    const int qrow0 = cx ? TL + b * 256 : b * 4096 + qb * 256, qpos0 = cx ? 0 : qb * 256, nkt = cx ? 4 : 68;
                    if (mla_safe(b, h)) attn_unit<96, true>(lds, QM + h * 96, 512, KVM + h * 128, 512, U + C_KPE, KVM + h * 128 + 64, 512, YCAT + 256 + h * 64, qrow0, qpos0, nkt, TL + b * 256, b * 4096, !cx, C_MLA, tid);
                    else attn_unit<96, false>(lds, QM + h * 96, 512, KVM + h * 128, 512, U + C_KPE, KVM + h * 128 + 64, 512, YCAT + 256 + h * 64, qrow0, qpos0, nkt, TL + b * 256, b * 4096, !cx, C_MLA, tid);
                }
#pragma unroll 1
                for (int r = 0; r < ng; ++r) {
                    const bool cx = (r == 2);
                    const int stream = xcd * 2 + (r & 1), bh = bid & 31;
                    const int b = cx ? (bh >> 2) : (stream >> 1), kvh = cx ? ((bh & 3) >> 1) : (stream & 1), h = cx ? (bh & 3) : kvh * 2 + (j >> 4), qb = j & 15;
                    const int qrow0 = cx ? TL + b * 256 : b * 4096 + qb * 256, qpos0 = cx ? 0 : qb * 256, nkt = cx ? 4 : 68;
                    if (gqa_safe) attn_unit<64, true>(lds, U + C_GQ + h * 64, DINP, U + C_GK + kvh * 64, DINP, nullptr, U + C_GV + kvh * 64, DINP, YCAT + 512 + h * 64, qrow0, qpos0, nkt, TL + b * 256, b * 4096, !cx, 1.0f, tid);
                    else attn_unit<64, false>(lds, U + C_GQ + h * 64, DINP, U + C_GK + kvh * 64, DINP, nullptr, U + C_GV + kvh * 64, DINP, YCAT + 512 + h * 64, qrow0, qpos0, nkt, TL + b * 256, b * 4096, !cx, 1.0f, tid);
                }
            }
            {
                PHASE_IDS();
                constexpr int VS2 = 264;
                LAS unsigned char* VT = lds;
                LAS float* YX = (LAS float*)(lds + 17408);
                const int c0 = last ? 2 : 0, nC = 34 - c0, nU = NB * 4 * nC;
                const int li = lane & 31, hi = lane >> 5, qg = wave & 3, dir = wave >> 2;
                for (int uu = (bid + 192) % G; uu < nU; uu += G) {
                    const int b = uu / (4 * nC), h = (uu / nC) & 3, c = c0 + uu % nC;
                    const int rowbase = (c < 2) ? TL + b * 256 + c * 128 : b * 4096 + (c - 2) * 128;
                    const float lg2 = MOD[DEPTH * 9 * NMOD + l * 8 + dir * 4 + h];
                    const float kscale = 0.17677669529663687f;
                    u32x4 vst[2];
#pragma unroll
                    for (int e = 0; e < 2; ++e) { const int idx = tid + 512 * e, key = idx >> 3, dch = idx & 7;
                        vst[e] = *(const u32x4*)(U + (size_t)(rowbase + key) * DINP + C_RV + h * 64 + 8 * dch); }
                    const int qi = 32 * qg + li; const size_t rowi = (size_t)(rowbase + qi);
                    bf16x8 qf[2];
#pragma unroll
                    for (int s = 0; s < 2; ++s) qf[s] = *(const bf16x8*)(U + rowi * DINP + C_RQ + h * 32 + 16 * s + 8 * hi);
                    bf16x8 kfa[4][2], spf[2][2]; u32x2 gtv[8];
#pragma unroll
                    for (int jt = 0; jt < 4; ++jt)
#pragma unroll
                        for (int s = 0; s < 2; ++s) kfa[jt][s] = *(const bf16x8*)(U + (size_t)(rowbase + 32 * jt + li) * DINP + C_RK + h * 32 + 16 * s + 8 * hi);
                    { const bf16_t* sp = SPT + ((((size_t)(b * 4 + h) * 34 + c) * 2 + dir) * 2048);
#pragma unroll
                      for (int s = 0; s < 2; ++s) { spf[0][s] = *(const bf16x8*)(sp + li * 32 + 16 * s + 8 * hi); spf[1][s] = *(const bf16x8*)(sp + (32 + li) * 32 + 16 * s + 8 * hi); } }
                    { const bf16_t* gp0 = U + rowi * DINP + (dir == 0 ? C_GF : C_GB) + h * 64;
#pragma unroll
                      for (int dt = 0; dt < 2; ++dt)
#pragma unroll
                          for (int rg = 0; rg < 4; ++rg) gtv[dt * 4 + rg] = *(const u32x2*)(gp0 + 32 * dt + 8 * rg + 4 * hi); }
                    __syncthreads();
#pragma unroll
                    for (int e = 0; e < 2; ++e) { const int idx = tid + 512 * e, key = idx >> 3, dch = idx & 7;
                        *(LAS u32x4*)(VT + (key >> 2) * 512 + (dch >> 2) * 256 + (key & 3) * 64 + (dch & 3) * 16) = vst[e]; }
                    __syncthreads();
                    f32x16 O0, O1;
#pragma unroll
                    for (int r = 0; r < 16; ++r) { O0[r] = 0.f; O1[r] = 0.f; }
#pragma unroll
                    for (int jt = 0; jt < 4; ++jt) {
                        if (dir == 0 ? (jt > qg) : (jt < qg)) continue;
                        f32x16 S;
#pragma unroll
                        for (int r = 0; r < 16; ++r) S[r] = 0.f;
#pragma unroll
                        for (int s = 0; s < 2; ++s) {
                            S = __builtin_amdgcn_mfma_f32_32x32x16_bf16(kfa[jt][s], qf[s], S, 0, 0, 0);
                        }
#pragma unroll
                        for (int r = 0; r < 16; ++r) {
                            const int j = 32 * jt + crow(r, hi);
                            const int diff = (dir == 0) ? (qi - j) : (j - qi);
                            const float w = (diff >= 0) ? fexp2(lg2 * (float)diff) * kscale : 0.f;
                            S[r] *= w;
                        }
#pragma unroll
                        for (int e = 0; e < 2; ++e) {
                            u32x4 w0;
                            w0.x = cvt_pk_bf16(S[8 * e + 0], S[8 * e + 1]); w0.y = cvt_pk_bf16(S[8 * e + 2], S[8 * e + 3]); w0.z = cvt_pk_bf16(S[8 * e + 4], S[8 * e + 5]); w0.w = cvt_pk_bf16(S[8 * e + 6], S[8 * e + 7]);
                            const bf16x8 pb = __builtin_bit_cast(bf16x8, w0);
                            const int ks = 2 * jt + e;
                            const LAS unsigned char* vb = VT + hi * 512 + ((lane & 15) >> 2) * 64 + ((lane >> 4) & 1) * 32 + (lane & 3) * 8 + ks * 2048;
                            const v4i16_t l0 = vtr(vb), h0 = vtr(vb + 1024), l1 = vtr(vb + 256), h1 = vtr(vb + 1024 + 256);
                            const bf16x8 a0 = __builtin_shufflevector(l0, h0, 0, 1, 2, 3, 4, 5, 6, 7), a1 = __builtin_shufflevector(l1, h1, 0, 1, 2, 3, 4, 5, 6, 7);
                            O0 = __builtin_amdgcn_mfma_f32_32x32x16_bf16(a0, pb, O0, 0, 0, 0);
                            O1 = __builtin_amdgcn_mfma_f32_32x32x16_bf16(a1, pb, O1, 0, 0, 0);
                        }
                    }
                    {
                        f32x16 X0, X1;
#pragma unroll
                        for (int r = 0; r < 16; ++r) { X0[r] = 0.f; X1[r] = 0.f; }
#pragma unroll
                        for (int s = 0; s < 2; ++s) {
                            X0 = __builtin_amdgcn_mfma_f32_32x32x16_bf16(spf[0][s], qf[s], X0, 0, 0, 0);
                            X1 = __builtin_amdgcn_mfma_f32_32x32x16_bf16(spf[1][s], qf[s], X1, 0, 0, 0);
                        }
                        const float dec = fexp2(lg2 * (float)(dir == 0 ? qi + 1 : 128 - qi));
#pragma unroll
                        for (int r = 0; r < 16; ++r) { O0[r] += dec * X0[r]; O1[r] += dec * X1[r]; }
                    }
                    float ss = 0.f;
#pragma unroll
                    for (int r = 0; r < 16; ++r) ss += O0[r] * O0[r] + O1[r] * O1[r];
                    ss += shx(ss, 32, lane);
                    const float rs = rsqrtf(ss * (1.f / 64.f) + EPS);
                    const float* ng = IN(I_RNG) + ((size_t)(l * 2 + dir) * 4 + h) * 64;
                    f32x4 yv[8];
#pragma unroll
                    for (int dt = 0; dt < 2; ++dt)
#pragma unroll
                        for (int rg = 0; rg < 4; ++rg) {
                            const int d0 = 32 * dt + 8 * rg + 4 * hi;
                            const u32x2 gt2 = gtv[dt * 4 + rg]; const f32x4 gn = *(const f32x4*)(ng + d0);
                            const float g0 = bflo(gt2.x), g1 = bfhi(gt2.x), g2 = bflo(gt2.y), g3 = bfhi(gt2.y);
                            f32x4 y;
                            if (dt == 0) { y.x = O0[4 * rg]; y.y = O0[4 * rg + 1]; y.z = O0[4 * rg + 2]; y.w = O0[4 * rg + 3]; }
                            else { y.x = O1[4 * rg]; y.y = O1[4 * rg + 1]; y.z = O1[4 * rg + 2]; y.w = O1[4 * rg + 3]; }
                            y = y * rs * gn;
                            y.x *= g0 * sigmoidf_(g0); y.y *= g1 * sigmoidf_(g1); y.z *= g2 * sigmoidf_(g2); y.w *= g3 * sigmoidf_(g3);
                            yv[dt * 4 + rg] = y;
                        }
                    if (dir == 1) {
#pragma unroll
                        for (int dt = 0; dt < 2; ++dt)
#pragma unroll
                            for (int rg = 0; rg < 4; ++rg) *(LAS f32x4*)(YX + qi * 64 + 32 * dt + 8 * rg + 4 * hi) = yv[dt * 4 + rg];
                    }
                    __syncthreads();
                    if (dir == 0) {
                        bf16_t* yo = YCAT + rowi * DM + 768 + h * 64;
#pragma unroll
                        for (int dt = 0; dt < 2; ++dt)
#pragma unroll
                            for (int rg = 0; rg < 4; ++rg) {
                                const int d0 = 32 * dt + 8 * rg + 4 * hi;
                                const f32x4 y = yv[dt * 4 + rg] + *(const LAS f32x4*)(YX + qi * 64 + d0);
                                u32x2 w2; w2.x = cvt_pk_bf16(y.x, y.y); w2.y = cvt_pk_bf16(y.z, y.w);
                                *(u32x2*)(yo + d0) = w2;
                            }
                    }
                }
                __syncthreads();
            }
        }
        GRID_BAR();

        {
            PHASE_IDS();
            pg8::Gemm g{YCAT, WOUTT, Mrows, DM, DM, DM}; pg8::StaticOrder S; S.init(Mrows, DM, G, bid, g.K);
            pg8::EpiRes E{xlat_in, xctx_in, OUTP, CX, modl + 2 * DM, nullptr};
            pg8::gemm_phase<pg8::EpiRes, pg8::StaticOrder>(lds, g, S, E, tid);
        }
        GRID_BAR();

        { PHASE_IDS();
        for (int rep = 0; rep < PROBE_AUX; ++rep)
        for (int m = gw; m < Mrows; m += NGW) {
            const bool isl = m < TL; const int j = isl ? (m >> 12) : 8;
            const float* xr = isl ? OUTP + (size_t)m * DM : CX + (size_t)(m - TL) * DM;
            norm_row_mod(xr, modl + (size_t)j * NMOD + 3 * DM, modl + (size_t)j * NMOD + 4 * DM, XN + (size_t)m * DM, lane);
        }
        }
        GRID_BAR();

        {
            PHASE_IDS();
            pg8::Gemm g{XN, W1T, Mrows, DFF, DM, DM}; pg8::StaticOrder S; S.init(Mrows, DFF, G, bid, g.K);
            pg8::EpiBf16<1> E{HB, DFF};
            for (int rep = 0; rep < PROBE_GEMM; ++rep)
            pg8::gemm_phase<pg8::EpiBf16<1>, pg8::StaticOrder>(lds, g, S, E, tid);
        }
        GRID_BAR();

        {
            PHASE_IDS();
            pg8::Gemm g{HB, W2T, Mrows, DM, DFF, DFF}; pg8::StaticOrder S; S.init(TL, DM, G, bid, g.K);
            if (!last) S.extra(TL / 256, TC / 256, 4);
            pg8::EpiRes E{OUTP, CX, OUTP, CX, modl + 5 * DM, last ? (float*)nullptr : (float*)(ws + WS_KVM)};
            pg8::gemm_phase<pg8::EpiRes, pg8::StaticOrder>(lds, g, S, E, tid);
        }
        GRID_BAR();
    }

    { PHASE_IDS();
    for (int m = gw; m < TL; m += NGW) {
        f32x4* xr = (f32x4*)(OUTP + (size_t)m * DM) + lane;
        f32x4 v[4]; float s = 0.f;
#pragma unroll
        for (int j = 0; j < 4; ++j) { v[j] = xr[64 * j]; s += (v[j].x * v[j].x + v[j].y * v[j].y) + (v[j].z * v[j].z + v[j].w * v[j].w); }
        const float rstd = rsqrtf(wave_sum(s, lane) * (1.f / DM) + EPS);
#pragma unroll
        for (int j = 0; j < 4; ++j) xr[64 * j] = v[j] * rstd * ((const f32x4*)IN(I_FG))[lane + 64 * j];
    }
    }
}

extern "C" void kernel_launch(void* const* d_in, const int* in_sizes, int n_in, void* d_out, int out_size, void* d_ws, size_t ws_size, hipStream_t stream) {
    static int grid = 0;
    if (grid == 0) {
        int dev = 0, cus = 0, per_cu = 0;
        (void)hipGetDevice(&dev);
        (void)hipDeviceGetAttribute(&cus, hipDeviceAttributeMultiprocessorCount, dev);
        (void)hipFuncSetAttribute((const void*)mega_fwd, hipFuncAttributeMaxDynamicSharedMemorySize, LDS_BYTES);
        (void)hipOccupancyMaxActiveBlocksPerMultiprocessor(&per_cu, (const void*)mega_fwd, 512, LDS_BYTES);
        if (per_cu < 1) per_cu = 1;
        grid = cus * per_cu;
        if (grid != 256) fprintf(stderr, "kernel_launch: grid %d (expected 256)\n", grid);
        if (ws_size < WS_END || n_in != 24) { fprintf(stderr, "kernel_launch: ws %zu < %zu or n_in %d\n", ws_size, (size_t)WS_END, n_in); grid = -1; }
    }
    if (grid < 0) return;
    Args a{};
    for (int i = 0; i < 24; ++i) a.in[i] = (const float*)d_in[i];
    a.out = (float*)d_out; a.ws = (unsigned char*)d_ws;
    void* args[] = {&a};
    hipError_t e = hipLaunchCooperativeKernel((const void*)mega_fwd, dim3(grid), dim3(512), args, LDS_BYTES, stream);
    if (e != hipSuccess) fprintf(stderr, "cooperative launch failed: %s (grid %d)\n", hipGetErrorString(e), grid);
}
```
